# Optimizing an MI355X kernel written in HIP

```python
import jax, jax.numpy as jnp
from jax import lax
import numpy as np

D_MODEL = 1024
BATCH = 1
SEQ = 16384
DEPTH = 4

ATT_HEADS = 8
ATT_KV_HEADS = 2
HEAD_DIM = 64
WINDOW = 128
ATT_BLOCK = 128
ATT_WIDTH = ATT_HEADS * HEAD_DIM
KV_WIDTH = ATT_KV_HEADS * HEAD_DIM
CONV_WIDTH = 512
CONV_K = 3
POOL_SIZES = (2, 4, 8, 16)
POOL_GROUP = 128
POOL_WIDTH = 512
SGU_GROUPS = 4
SGU_CHUNK = 128
SGU_WIDTH = 512
SGU_GROUP = SGU_WIDTH // SGU_GROUPS
N_BRANCH = 4
BRANCH_WIDTH = 512
IN_COLS = ATT_WIDTH + 2 * KV_WIDTH + 3 * CONV_WIDTH + POOL_WIDTH + 2 * SGU_WIDTH + N_BRANCH * D_MODEL
FFN_HIDDEN = 2816
N_EXPERTS = 8
TOP_K = 2
N_DENSE = (DEPTH + 1) // 2
N_MOE = DEPTH // 2
RMS_EPS = 1e-6
NEG_INF = -1e30

kernel_name = "hybrid_gated_multimixer_moe_trunk"


def rmsnorm(x, g):
    xf = x.astype(jnp.float32)
    y = xf * lax.rsqrt(jnp.mean(xf * xf, axis=-1, keepdims=True) + RMS_EPS)
    return (y * g.astype(jnp.float32)).astype(x.dtype)


def sliding_window_attention(q, k, v, sinks):
    b, s, _ = q.shape
    nb = s // ATT_BLOCK
    grp = ATT_HEADS // ATT_KV_HEADS
    qb = q.reshape(b, nb, ATT_BLOCK, ATT_KV_HEADS, grp, HEAD_DIM)

    def band(t):
        t = t.reshape(b, nb, ATT_BLOCK, ATT_KV_HEADS, HEAD_DIM)
        prev = jnp.pad(t, ((0, 0), (1, 0), (0, 0), (0, 0), (0, 0)))[:, :-1]
        return jnp.concatenate([prev, t], axis=2)

    kb, vb = band(k), band(v)
    scores = jnp.einsum('bnqkgd,bnskd->bnkgqs', qb, kb).astype(jnp.float32) * (HEAD_DIM ** -0.5)
    qi = jnp.arange(ATT_BLOCK)[:, None]
    kj = jnp.arange(2 * ATT_BLOCK)[None, :]
    rel = qi + ATT_BLOCK - kj
    local = (rel >= 0) & (rel < WINDOW)
    kpos = jnp.arange(nb)[:, None] * ATT_BLOCK - ATT_BLOCK + kj
    valid = local[None] & (kpos >= 0)[:, None, :]
    scores = jnp.where(valid[None, :, None, None], scores, NEG_INF)
    sink_col = jnp.broadcast_to(
        sinks.astype(jnp.float32).reshape(1, 1, ATT_KV_HEADS, grp, 1, 1), scores.shape[:-1] + (1,))
    probs = jax.nn.softmax(jnp.concatenate([scores, sink_col], axis=-1), axis=-1)[..., :-1]
    out = jnp.einsum('bnkgqs,bnskd->bnqkgd', probs.astype(v.dtype), vb)
    return out.reshape(b, s, ATT_WIDTH)


def short_conv_mixer(bgate, cgate, xin, conv_w):
    z = cgate * xin
    s = z.shape[1]
    zp = jnp.pad(z, ((0, 0), (CONV_K - 1, 0), (0, 0)))
    y = sum(conv_w[j] * zp[:, j:j + s] for j in range(CONV_K))
    return bgate * y


def multiscale_pool_mixer(p, pool_w, pool_scale):
    b, s, _ = p.shape
    pf = p.astype(jnp.float32)
    cs = jnp.pad(jnp.cumsum(pf, axis=1), ((0, 0), (1, 0), (0, 0)))
    t = jnp.arange(s)
    outs = []
    for g, w in enumerate(POOL_SIZES):
        sl = slice(g * POOL_GROUP, (g + 1) * POOL_GROUP)
        start = jnp.maximum(t + 1 - w, 0)
        cnt = (t + 1 - start).astype(jnp.float32)
        win_sum = cs[:, 1:, sl] - cs[:, start, sl]
        outs.append(win_sum / cnt[None, :, None] - pf[..., sl])
    pooled = jnp.stack(outs, axis=2).astype(p.dtype)
    y = jnp.einsum('bsgc,gcd->bsgd', pooled, pool_w).reshape(b, s, POOL_WIDTH)
    return y * pool_scale


def spatial_gating_mixer(u, v, sgu_w, sgu_b):
    b, s, _ = u.shape
    nc = s // SGU_CHUNK
    mask = jnp.tril(jnp.ones((SGU_CHUNK, SGU_CHUNK), dtype=bool))
    ws = jnp.where(mask[None], sgu_w, jnp.zeros_like(sgu_w))
    vc = v.reshape(b, nc, SGU_CHUNK, SGU_GROUPS, SGU_GROUP)
    mixed = jnp.einsum('gts,bnsgc->bntgc', ws, vc) + sgu_b.T[None, None, :, :, None]
    return u * mixed.reshape(b, s, SGU_WIDTH)


def hybrid_mixer(h, w_in, sinks, conv_w, pool_w, pool_scale, sgu_w, sgu_b, w_branch, w_out):
    b, s, _ = h.shape
    proj = h @ w_in
    sizes = [ATT_WIDTH, KV_WIDTH, KV_WIDTH, CONV_WIDTH, CONV_WIDTH, CONV_WIDTH,
             POOL_WIDTH, SGU_WIDTH, SGU_WIDTH, N_BRANCH * D_MODEL]
    splits = [int(c) for c in np.cumsum(sizes)[:-1]]
    q, k, v, cb, cc, cx, p, u, sv, g = jnp.split(proj, splits, axis=-1)
    y_att = sliding_window_attention(q, k, v, sinks)
    y_conv = short_conv_mixer(cb, cc, cx, conv_w)
    y_pool = multiscale_pool_mixer(p, pool_w, pool_scale)
    y_sgu = spatial_gating_mixer(u, sv, sgu_w, sgu_b)
    branches = jnp.stack([y_att, y_conv, y_pool, y_sgu], axis=2)
    up = jnp.einsum('bsnc,ncd->bsnd', branches, w_branch)
    gates = jax.nn.sigmoid(g.reshape(b, s, N_BRANCH, D_MODEL))
    merged = jnp.sum(gates * up, axis=2)
    return merged @ w_out


def swiglu(h, w_gate, w_up, w_down):
    return (jax.nn.silu(h @ w_gate) * (h @ w_up)) @ w_down


def moe_swiglu(h, router_w, router_b, w_gate, w_up, w_down):
    logits = (h @ router_w).astype(jnp.float32) + router_b.astype(jnp.float32)
    top_val, top_idx = lax.top_k(logits, TOP_K)
    top_w = jax.nn.softmax(top_val, axis=-1)
    combine = jnp.sum(jax.nn.one_hot(top_idx, N_EXPERTS, dtype=jnp.float32) * top_w[..., None], axis=-2)
    y = jnp.zeros_like(h)
    for e in range(N_EXPERTS):
        y = y + combine[..., e:e + 1].astype(h.dtype) * swiglu(h, w_gate[e], w_up[e], w_down[e])
    return y


def setup_inputs(seed: int = 0) -> dict:
    key = jax.random.key(seed)
    ks = jax.random.split(key, 24)
    nrm = lambda k, shape, scale: jax.random.normal(k, shape, jnp.float32) * scale
    gain = lambda k, shape: 1.0 + 0.05 * jax.random.normal(k, shape, jnp.float32)
    return {
        "x": nrm(ks[0], (BATCH, SEQ, D_MODEL), 1.0),
        "ln_mix_g": gain(ks[1], (DEPTH, D_MODEL)),
        "w_in": nrm(ks[2], (DEPTH, D_MODEL, IN_COLS), D_MODEL ** -0.5),
        "attn_sinks": nrm(ks[3], (DEPTH, ATT_HEADS), 1.0),
        "conv_w": nrm(ks[4], (DEPTH, CONV_K, CONV_WIDTH), CONV_K ** -0.5),
        "pool_w": nrm(ks[5], (DEPTH, len(POOL_SIZES), POOL_GROUP, POOL_GROUP), POOL_GROUP ** -0.5),
        "pool_scale": gain(ks[6], (DEPTH, POOL_WIDTH)),
        "sgu_w": nrm(ks[7], (DEPTH, SGU_GROUPS, SGU_CHUNK, SGU_CHUNK), SGU_CHUNK ** -0.5),
        "sgu_b": gain(ks[8], (DEPTH, SGU_GROUPS, SGU_CHUNK)),
        "w_branch": nrm(ks[9], (DEPTH, N_BRANCH, BRANCH_WIDTH, D_MODEL), BRANCH_WIDTH ** -0.5),
        "w_out": nrm(ks[10], (DEPTH, D_MODEL, D_MODEL), D_MODEL ** -0.5),
        "ln_ffn_g": gain(ks[11], (DEPTH, D_MODEL)),
        "dense_w_gate": nrm(ks[12], (N_DENSE, D_MODEL, FFN_HIDDEN), D_MODEL ** -0.5),
        "dense_w_up": nrm(ks[13], (N_DENSE, D_MODEL, FFN_HIDDEN), D_MODEL ** -0.5),
        "dense_w_down": nrm(ks[14], (N_DENSE, FFN_HIDDEN, D_MODEL), FFN_HIDDEN ** -0.5),
        "router_w": nrm(ks[15], (N_MOE, D_MODEL, N_EXPERTS), D_MODEL ** -0.5),
        "router_b": nrm(ks[16], (N_MOE, N_EXPERTS), 0.01),
        "moe_w_gate": nrm(ks[17], (N_MOE, N_EXPERTS, D_MODEL, FFN_HIDDEN), D_MODEL ** -0.5),
        "moe_w_up": nrm(ks[18], (N_MOE, N_EXPERTS, D_MODEL, FFN_HIDDEN), D_MODEL ** -0.5),
        "moe_w_down": nrm(ks[19], (N_MOE, N_EXPERTS, FFN_HIDDEN, D_MODEL), FFN_HIDDEN ** -0.5),
        "ln_final_g": gain(ks[20], (D_MODEL,)),
    }


def reference(x, ln_mix_g, w_in, attn_sinks, conv_w, pool_w, pool_scale, sgu_w, sgu_b, w_branch, w_out,
              ln_ffn_g, dense_w_gate, dense_w_up, dense_w_down, router_w, router_b,
              moe_w_gate, moe_w_up, moe_w_down, ln_final_g):
    for layer in range(DEPTH):
        h = rmsnorm(x, ln_mix_g[layer])
        x = x + hybrid_mixer(h, w_in[layer], attn_sinks[layer], conv_w[layer], pool_w[layer],
                             pool_scale[layer], sgu_w[layer], sgu_b[layer], w_branch[layer], w_out[layer])
        h = rmsnorm(x, ln_ffn_g[layer])
        i = layer // 2
        if layer % 2 == 0:
            x = x + swiglu(h, dense_w_gate[i], dense_w_up[i], dense_w_down[i])
        else:
            x = x + moe_swiglu(h, router_w[i], router_b[i], moe_w_gate[i], moe_w_up[i], moe_w_down[i])
    return rmsnorm(x, ln_final_g)
```

```cpp
#include <hip/hip_runtime.h>
#include <cstdio>
#include <cstdint>

#define MOE0_F8 1
#define DENSE_F8_MASK 2
#ifndef MK_PER_PHASE
#define MK_PER_PHASE 0
#endif

namespace pg8 {
#define PG8_LAS __attribute__((address_space(3)))
typedef unsigned short bf16_t;
typedef short bf16x8 __attribute__((ext_vector_type(8)));
typedef float f32x4 __attribute__((ext_vector_type(4)));
typedef unsigned u32x4 __attribute__((ext_vector_type(4)));
typedef unsigned u32x2 __attribute__((ext_vector_type(2)));
constexpr int BM = 256, BK = 64, HALF = 128, HTB = HALF * BK * 2, STAGE_BYTES = 8 * HTB, NXCD = 8, WGM = 8;

__host__ __device__ __forceinline__ int lds_byte(int r, int c) { const int st = (r >> 4) * 2 + (c >> 5), rr = r & 15, cc = c & 31, ob = rr * 64 + cc * 2; return st * 1024 + (ob ^ (((ob >> 9) & 1) << 5)); }
__host__ __device__ __forceinline__ void stage_rc(int b, int& R, int& C) { const int st = b / 1024, sb = b % 1024, swz = sb ^ (((sb >> 9) & 1) << 5); R = (st >> 1) * 16 + swz / 64; C = (st & 1) * 32 + (swz % 64) / 2; }
__host__ __device__ __forceinline__ int perm32(int rho) { const int n = rho >> 4, i = rho & 15; return 8 * (i >> 2) + 4 * n + (i & 3); }

struct Unit { int pm, pn, pa, hm; };
struct Gemm { const bf16_t* A; const bf16_t* Bt; int K; };

struct StaticOrder {
    int nM, nN, nwg, G, c;
    __host__ __device__ __forceinline__ void init(int nM_, int nN_, int G_, int c_) { nM = nM_; nN = nN_; nwg = nM * nN; G = G_; c = c_; }
    __host__ __device__ __forceinline__ bool next(int i, Unit& u) const { return at((long)i * G + c, u); }
    __host__ __device__ __forceinline__ bool next_split(int i, Unit& u) const {
        const int nfr = nwg / G, rem = nwg - nfr * G;
        if (i < nfr || rem == 0 || 2 * rem > G) return next(i, u);
        if (i > nfr || c >= 2 * rem) return false;
        if (!at((long)nfr * G + (c >> 1), u)) return false;
        u.hm = 1 + (c & 1); return true;
    }
    __host__ __device__ __forceinline__ bool at(long L, Unit& u) const {
        if (L >= nwg) return false;
        int wgid = (int)L; { const int q = nwg / NXCD, r = nwg % NXCD, xcd = wgid % NXCD, off = wgid / NXCD; wgid = (xcd < r ? xcd * (q + 1) : r * (q + 1) + (xcd - r) * q) + off; }
        const int nig = WGM * nN, gid = wgid / nig, fm = gid * WGM, gsz = (nM - fm) < WGM ? (nM - fm) : WGM;
        u.pm = fm + ((wgid % nig) % gsz); u.pn = (wgid % nig) / gsz; u.pa = u.pm; u.hm = 0; return true;
    }
};

__device__ __forceinline__ unsigned cvt_pk_bf16(float lo, float hi) { unsigned r; asm volatile("v_cvt_pk_bf16_f32 %0, %1, %2" : "=v"(r) : "v"(lo), "v"(hi)); return r; }

typedef int i32x4 __attribute__((ext_vector_type(4)));
typedef int i32x8 __attribute__((ext_vector_type(8)));
template <bool F8, class Epi, class Sched>
__device__ __forceinline__ void gemm_phase(PG8_LAS unsigned char* lds, const Gemm g, const Sched& S, const Epi& E) {
    int tid_ = threadIdx.x; asm volatile("" : "+v"(tid_));
    const int tid = tid_, wid = __builtin_amdgcn_readfirstlane(tid >> 6), lane = tid & 63, wr = wid >> 2, wc = wid & 3, fr = lane & 15, fq = lane >> 4;
    int K_ = g.K; asm volatile("" : "+s"(K_));
    const int K = K_, nt = K / BK;
    unsigned voffA[2], voffB[2];
#pragma unroll
    for (int i = 0; i < 2; ++i) { int R, C; stage_rc(tid * 16 + i * 8192, R, C);
        voffA[i] = (unsigned)(R * K + C) * 2u; voffB[i] = (unsigned)(tid * 16 + i * 8192); }
    const size_t kstep = (size_t)(BK * 2);
    const size_t hstep = (size_t)HALF * K * 2;
    const size_t tstep = 2 * hstep;
    const size_t kstepB = 2 * HTB, hstepB = HTB;
    const unsigned ldsw = (unsigned)wid * 1024u;
    const int aoff = lds_byte(wr * 64 + fr, fq * 8), boff = lds_byte(wc * 32 + fr, fq * 8);
#define PG8_SA(b, h) (((b) * 2 + (h)) * HTB)
#define PG8_SB(b, h) ((4 + (b) * 2 + (h)) * HTB)
#define PG8_STAGE(bufoff, gbase, voff) do { _Pragma("unroll") for (int _i = 0; _i < 2; ++_i) \
        __builtin_amdgcn_global_load_lds((const unsigned*)((const char*)(gbase) + (voff)[_i]), (PG8_LAS unsigned*)(lds + (bufoff) + ldsw + _i * 8192), 16, 0, 0); } while (0)
#define PG8_LDA(dst, b, h) do { _Pragma("unroll") for (int m = 0; m < 4; ++m) { const bf16x8 x0_ = *(const PG8_LAS bf16x8*)(lds + PG8_SA(b, h) + aoff + m * 2048), x1_ = *(const PG8_LAS bf16x8*)(lds + PG8_SA(b, h) + aoff + m * 2048 + 1024); \
        if constexpr (F8) dst##8[m] = PG8_CAT(x0_, x1_); else { dst[m][0] = x0_; dst[m][1] = x1_; } } } while (0)
#define PG8_LDB(dst, b, h) do { _Pragma("unroll") for (int n = 0; n < 2; ++n) { const bf16x8 x0_ = *(const PG8_LAS bf16x8*)(lds + PG8_SB(b, h) + boff + n * 2048), x1_ = *(const PG8_LAS bf16x8*)(lds + PG8_SB(b, h) + boff + n * 2048 + 1024); \
        if constexpr (F8) dst##8[n] = PG8_CAT(x0_, x1_); else { dst[n][0] = x0_; dst[n][1] = x1_; } } } while (0)
#define PG8_CAT(x0, x1) __builtin_shufflevector(__builtin_bit_cast(i32x4, x0), __builtin_bit_cast(i32x4, x1), 0, 1, 2, 3, 4, 5, 6, 7)
#define PG8_MMA(ai, bj, At, Bt) do { __builtin_amdgcn_s_setprio(1); \
        if constexpr (F8) { _Pragma("unroll") for (int m = 0; m < 4; ++m) _Pragma("unroll") for (int n = 0; n < 2; ++n) \
            asm volatile("v_mfma_f32_16x16x128_f8f6f4 %0, %1, %2, %0" : "+v"(acc[ai][bj][m][n]) : "v"(Bt##8[n]), "v"(At##8[m])); } \
        else { _Pragma("unroll") for (int m = 0; m < 4; ++m) _Pragma("unroll") for (int n = 0; n < 2; ++n) _Pragma("unroll") for (int k = 0; k < 2; ++k) \
            acc[ai][bj][m][n] = __builtin_amdgcn_mfma_f32_16x16x32_bf16(Bt[n][k], At[m][k], acc[ai][bj][m][n], 0, 0, 0); } \
        __builtin_amdgcn_s_setprio(0); } while (0)
#define PG8_WAIT_V(n) asm volatile("s_waitcnt vmcnt(" #n ")" ::: "memory")
#define PG8_WAIT_L(n) asm volatile("s_waitcnt lgkmcnt(" #n ")" ::: "memory")
#define PG8_BAR __builtin_amdgcn_s_barrier()
#define PG8_SCHED __builtin_amdgcn_sched_barrier(0)
    Unit cur, nxt; int ui = 0;
    if (!S.next(0, cur)) return;
    f32x4 acc[2][2][4][2];
#pragma unroll
    for (int a = 0; a < 2; ++a)
#pragma unroll
        for (int b = 0; b < 2; ++b)
#pragma unroll
            for (int m = 0; m < 4; ++m)
#pragma unroll
                for (int n = 0; n < 2; ++n) acc[a][b][m][n] = (f32x4){0.f, 0.f, 0.f, 0.f};
    bf16x8 At[4][2], B0[2][2], B1[2][2]; i32x8 At8[4], B08[2], B18[2];
    const char* cA = (const char*)g.A + (size_t)cur.pa * tstep; const char* cB = (const char*)g.Bt + (size_t)cur.pn * tstep;
    PG8_STAGE(PG8_SB(0, 0), cB, voffB); PG8_STAGE(PG8_SB(0, 1), cB + hstepB, voffB); PG8_STAGE(PG8_SA(0, 0), cA, voffA); PG8_STAGE(PG8_SA(0, 1), cA + hstep, voffA);
    if (wr == 1) PG8_BAR;
    PG8_WAIT_V(2); PG8_BAR;
    PG8_STAGE(PG8_SB(1, 0), cB + kstepB, voffB); PG8_STAGE(PG8_SA(1, 0), cA + kstep, voffA); PG8_STAGE(PG8_SB(1, 1), cB + hstepB + kstepB, voffB);
    PG8_WAIT_V(6); PG8_BAR;
    for (;;) {
        const bool has_next = S.next(ui + 1, nxt);
        const char* nA = has_next ? (const char*)g.A + (size_t)nxt.pa * tstep : cA; const char* nB = has_next ? (const char*)g.Bt + (size_t)nxt.pn * tstep : cB;
#pragma clang loop unroll(disable)
        for (int t = 0; t < nt; t += 2) {
            const bool last = (t == nt - 2);
            const char* a1 = cA + (size_t)(t + 1) * kstep;
            const char* a2 = last ? nA : cA + (size_t)(t + 2) * kstep; const char* b2 = last ? nB : cB + (size_t)(t + 2) * kstepB;
            const char* a3 = a2 + kstep; const char* b3 = b2 + kstepB;
            PG8_LDB(B0, 0, 0); PG8_LDB(B1, 0, 1); PG8_SCHED; if (cur.hm != 2) PG8_LDA(At, 0, 0); PG8_STAGE(PG8_SA(1, 1), a1 + hstep, voffA);
            PG8_WAIT_V(8); PG8_WAIT_L(0); PG8_BAR; if (cur.hm != 2) { PG8_MMA(0, 0, At, B0); PG8_MMA(0, 1, At, B1); } PG8_BAR; PG8_SCHED;
            if (cur.hm != 1) PG8_LDA(At, 0, 1); PG8_STAGE(PG8_SB(0, 0), b2, voffB); PG8_STAGE(PG8_SB(0, 1), b2 + hstepB, voffB); PG8_STAGE(PG8_SA(0, 0), a2, voffA);
            PG8_WAIT_V(8); PG8_WAIT_L(0); PG8_BAR; if (cur.hm != 1) { PG8_MMA(1, 0, At, B0); PG8_MMA(1, 1, At, B1); } PG8_BAR; PG8_SCHED;
            PG8_LDB(B0, 1, 0); PG8_LDB(B1, 1, 1); PG8_SCHED; if (cur.hm != 2) PG8_LDA(At, 1, 0); PG8_STAGE(PG8_SA(0, 1), a2 + hstep, voffA);
            PG8_WAIT_V(8); PG8_WAIT_L(0); PG8_BAR; if (cur.hm != 2) { PG8_MMA(0, 0, At, B0); PG8_MMA(0, 1, At, B1); } PG8_BAR; PG8_SCHED;
            if (cur.hm != 1) PG8_LDA(At, 1, 1); PG8_STAGE(PG8_SB(1, 0), b3, voffB); PG8_STAGE(PG8_SB(1, 1), b3 + hstepB, voffB); PG8_STAGE(PG8_SA(1, 0), a3, voffA);
            PG8_WAIT_V(8); PG8_WAIT_L(0); PG8_BAR; if (cur.hm != 1) { PG8_MMA(1, 0, At, B0); PG8_MMA(1, 1, At, B1); } PG8_BAR; PG8_SCHED;
        }
        if (wr == 0) PG8_BAR;
        if constexpr (F8) asm volatile("s_nop 15\n\ts_nop 15" ::: "memory");
        E(acc, cur, wr, wc, fr, fq);
        if (!has_next) break;
        if (E.zero_after(cur)) {
#pragma unroll
        for (int a = 0; a < 2; ++a)
#pragma unroll
            for (int b = 0; b < 2; ++b)
#pragma unroll
                for (int m = 0; m < 4; ++m)
#pragma unroll
                    for (int n = 0; n < 2; ++n) acc[a][b][m][n] = (f32x4){0.f, 0.f, 0.f, 0.f};
        }
        cur = nxt; cA = nA; cB = nB; ++ui;
        if (wr == 1) PG8_BAR;
    }
    PG8_WAIT_V(0);
    PG8_BAR;
#undef PG8_SA
#undef PG8_SB
#undef PG8_STAGE
#undef PG8_LDA
#undef PG8_LDB
#undef PG8_MMA
#undef PG8_CAT
#undef PG8_WAIT_V
#undef PG8_WAIT_L
#undef PG8_BAR
#undef PG8_SCHED
}

template <class Epi, class Sched>
__device__ __forceinline__ void gemm_phase_mixed(PG8_LAS unsigned char* lds, const bf16_t* A16, const bf16_t* B16, const unsigned char* A8, const unsigned char* B8, int nproj, const Sched& S, const Epi& E) {
    int tid_ = threadIdx.x; asm volatile("" : "+v"(tid_));
    const int tid = tid_, wid = __builtin_amdgcn_readfirstlane(tid >> 6), lane = tid & 63, wr = wid >> 2, wc = wid & 3, fr = lane & 15, fq = lane >> 4;
    int K_ = 1024; asm volatile("" : "+s"(K_));
    const int K = K_;
    unsigned voffA[2], voffB[2];
#pragma unroll
    for (int i = 0; i < 2; ++i) { int R, C; stage_rc(tid * 16 + i * 8192, R, C);
        voffA[i] = (unsigned)(R * K + C) * 2u; voffB[i] = (unsigned)(tid * 16 + i * 8192); }
    const size_t kstep = (size_t)(BK * 2);
    const size_t hstep16 = (size_t)HALF * K * 2, hstep8 = hstep16 >> 1;
    const size_t kstepB = 2 * HTB, hstepB = HTB;
    const unsigned ldsw = (unsigned)wid * 1024u;
    const int aoff = lds_byte(wr * 64 + fr, fq * 8), boff = lds_byte(wc * 32 + fr, fq * 8);
#define PG8_SA(b, h) (((b) * 2 + (h)) * HTB)
#define PG8_SB(b, h) ((4 + (b) * 2 + (h)) * HTB)
#define MX_OFF(v, f8) ((f8) ? (((v) >> 1) + (((v) & 127u) >> 1)) : (v))
#define PG8_STAGE(bufoff, gbase, voff, f8) do { _Pragma("unroll") for (int _i = 0; _i < 2; ++_i) \
        __builtin_amdgcn_global_load_lds((const unsigned*)((const char*)(gbase) + MX_OFF((voff)[_i], f8)), (PG8_LAS unsigned*)(lds + (bufoff) + ldsw + _i * 8192), 16, 0, 0); } while (0)
#define PG8_CAT(x0, x1) __builtin_shufflevector(__builtin_bit_cast(i32x4, x0), __builtin_bit_cast(i32x4, x1), 0, 1, 2, 3, 4, 5, 6, 7)
#define PG8_LDA(F8K, dst, b, h) do { _Pragma("unroll") for (int m = 0; m < 4; ++m) { const bf16x8 x0_ = *(const PG8_LAS bf16x8*)(lds + PG8_SA(b, h) + aoff + m * 2048), x1_ = *(const PG8_LAS bf16x8*)(lds + PG8_SA(b, h) + aoff + m * 2048 + 1024); \
        if constexpr (F8K) dst##8[m] = PG8_CAT(x0_, x1_); else { dst[m][0] = x0_; dst[m][1] = x1_; } } } while (0)
#define PG8_LDB(F8K, dst, b, h) do { _Pragma("unroll") for (int n = 0; n < 2; ++n) { const bf16x8 x0_ = *(const PG8_LAS bf16x8*)(lds + PG8_SB(b, h) + boff + n * 2048), x1_ = *(const PG8_LAS bf16x8*)(lds + PG8_SB(b, h) + boff + n * 2048 + 1024); \
        if constexpr (F8K) dst##8[n] = PG8_CAT(x0_, x1_); else { dst[n][0] = x0_; dst[n][1] = x1_; } } } while (0)
#define PG8_MMA(F8K, ai, bj, At, Bt) do { __builtin_amdgcn_s_setprio(1); \
        if constexpr (F8K) { _Pragma("unroll") for (int m = 0; m < 4; ++m) _Pragma("unroll") for (int n = 0; n < 2; ++n) \
            asm volatile("v_mfma_f32_16x16x128_f8f6f4 %0, %1, %2, %0" : "+v"(acc[ai][bj][m][n]) : "v"(Bt##8[n]), "v"(At##8[m])); } \
        else { _Pragma("unroll") for (int m = 0; m < 4; ++m) _Pragma("unroll") for (int n = 0; n < 2; ++n) _Pragma("unroll") for (int k = 0; k < 2; ++k) \
            acc[ai][bj][m][n] = __builtin_amdgcn_mfma_f32_16x16x32_bf16(Bt[n][k], At[m][k], acc[ai][bj][m][n], 0, 0, 0); } \
        __builtin_amdgcn_s_setprio(0); } while (0)
#define PG8_WAIT_V(n) asm volatile("s_waitcnt vmcnt(" #n ")" ::: "memory")
#define PG8_WAIT_L(n) asm volatile("s_waitcnt lgkmcnt(" #n ")" ::: "memory")
#define PG8_BAR __builtin_amdgcn_s_barrier()
#define PG8_SCHED __builtin_amdgcn_sched_barrier(0)
#define MX_UNIT(u, f8, pa, pb, hs, ntv) do { f8 = (u).pn >= nproj; \
        pa = f8 ? (const char*)A8 + (size_t)(u).pm * (2 * hstep8) : (const char*)A16 + (size_t)(u).pm * (2 * hstep16); \
        pb = f8 ? (const char*)B8 + (size_t)((u).pn - nproj) * (2 * hstep8) : (const char*)B16 + (size_t)(u).pn * (2 * hstep16); \
        hs = f8 ? hstep8 : hstep16; ntv = f8 ? (K >> 7) : (K >> 6); } while (0)
#define MX_KLOOP(F8K) _Pragma("clang loop unroll(disable)") \
        for (int t = 0; t < cnt; t += 2) { \
            const bool last = (t == cnt - 2); \
            const char* a1 = cA + (size_t)(t + 1) * kstep; \
            const bool f2 = last ? nF8 : cF8; const size_t hs2 = last ? nhs : chs; \
            const char* a2 = last ? nA : cA + (size_t)(t + 2) * kstep; const char* b2 = last ? nB : cB + (size_t)(t + 2) * kstepB; \
            const char* a3 = a2 + kstep; const char* b3 = b2 + kstepB; \
            PG8_LDB(F8K, B0, 0, 0); PG8_LDB(F8K, B1, 0, 1); PG8_SCHED; PG8_LDA(F8K, At, 0, 0); PG8_STAGE(PG8_SA(1, 1), a1 + chs, voffA, cF8); \
            PG8_WAIT_V(8); PG8_WAIT_L(0); PG8_BAR; PG8_MMA(F8K, 0, 0, At, B0); PG8_MMA(F8K, 0, 1, At, B1); PG8_BAR; PG8_SCHED; \
            PG8_LDA(F8K, At, 0, 1); PG8_STAGE(PG8_SB(0, 0), b2, voffB, false); PG8_STAGE(PG8_SB(0, 1), b2 + hstepB, voffB, false); PG8_STAGE(PG8_SA(0, 0), a2, voffA, f2); \
            PG8_WAIT_V(8); PG8_WAIT_L(0); PG8_BAR; PG8_MMA(F8K, 1, 0, At, B0); PG8_MMA(F8K, 1, 1, At, B1); PG8_BAR; PG8_SCHED; \
            PG8_LDB(F8K, B0, 1, 0); PG8_LDB(F8K, B1, 1, 1); PG8_SCHED; PG8_LDA(F8K, At, 1, 0); PG8_STAGE(PG8_SA(0, 1), a2 + hs2, voffA, f2); \
            PG8_WAIT_V(8); PG8_WAIT_L(0); PG8_BAR; PG8_MMA(F8K, 0, 0, At, B0); PG8_MMA(F8K, 0, 1, At, B1); PG8_BAR; PG8_SCHED; \
            PG8_LDA(F8K, At, 1, 1); PG8_STAGE(PG8_SB(1, 0), b3, voffB, false); PG8_STAGE(PG8_SB(1, 1), b3 + hstepB, voffB, false); PG8_STAGE(PG8_SA(1, 0), a3, voffA, f2); \
            PG8_WAIT_V(8); PG8_WAIT_L(0); PG8_BAR; PG8_MMA(F8K, 1, 0, At, B0); PG8_MMA(F8K, 1, 1, At, B1); PG8_BAR; PG8_SCHED; \
        }
    Unit cur, nxt; int ui = 0;
    if (!S.next(0, cur)) return;
    f32x4 acc[2][2][4][2];
#pragma unroll
    for (int a = 0; a < 2; ++a)
#pragma unroll
        for (int b = 0; b < 2; ++b)
#pragma unroll
            for (int m = 0; m < 4; ++m)
#pragma unroll
                for (int n = 0; n < 2; ++n) acc[a][b][m][n] = (f32x4){0.f, 0.f, 0.f, 0.f};
    bf16x8 At[4][2], B0[2][2], B1[2][2]; i32x8 At8[4], B08[2], B18[2];
    bool cF8; const char* cA; const char* cB; size_t chs; int cnt;
    MX_UNIT(cur, cF8, cA, cB, chs, cnt);
    PG8_STAGE(PG8_SB(0, 0), cB, voffB, false); PG8_STAGE(PG8_SB(0, 1), cB + hstepB, voffB, false); PG8_STAGE(PG8_SA(0, 0), cA, voffA, cF8); PG8_STAGE(PG8_SA(0, 1), cA + chs, voffA, cF8);
    if (wr == 1) PG8_BAR;
    PG8_WAIT_V(2); PG8_BAR;
    PG8_STAGE(PG8_SB(1, 0), cB + kstepB, voffB, false); PG8_STAGE(PG8_SA(1, 0), cA + kstep, voffA, cF8); PG8_STAGE(PG8_SB(1, 1), cB + hstepB + kstepB, voffB, false);
    PG8_WAIT_V(6); PG8_BAR;
    for (;;) {
        const bool has_next = S.next(ui + 1, nxt);
        bool nF8 = cF8; const char* nA = cA; const char* nB = cB; size_t nhs = chs; int nnt = cnt;
        if (has_next) MX_UNIT(nxt, nF8, nA, nB, nhs, nnt);
        if (cF8) { MX_KLOOP(true) } else { MX_KLOOP(false) }
        if (wr == 0) PG8_BAR;
        asm volatile("s_nop 15\n\ts_nop 15" ::: "memory");
        E(acc, cur, wr, wc, fr, fq);
        if (!has_next) break;
#pragma unroll
        for (int a = 0; a < 2; ++a)
#pragma unroll
            for (int b = 0; b < 2; ++b)
#pragma unroll
                for (int m = 0; m < 4; ++m)
#pragma unroll
                    for (int n = 0; n < 2; ++n) acc[a][b][m][n] = (f32x4){0.f, 0.f, 0.f, 0.f};
        cur = nxt; cA = nA; cB = nB; cF8 = nF8; chs = nhs; cnt = nnt; ++ui;
        if (wr == 1) PG8_BAR;
    }
    PG8_WAIT_V(0);
    PG8_BAR;
#undef PG8_SA
#undef PG8_SB
#undef MX_OFF
#undef MX_UNIT
#undef MX_KLOOP
#undef PG8_STAGE
#undef PG8_LDA
#undef PG8_LDB
#undef PG8_MMA
#undef PG8_CAT
#undef PG8_WAIT_V
#undef PG8_WAIT_L
#undef PG8_BAR
#undef PG8_SCHED
}
}

constexpr int M = 16384, D = 1024, NL = 4, NWAVES = 8;
constexpr int IN_COLS = 7936, PROJ_COLS = 3840, GATE_COLS = 4096, FF = 2816, NE = 8;
constexpr int PC_Q = 0, PC_K = 512, PC_V = 640, PC_CB = 768, PC_CC = 1280, PC_CX = 1792, PC_P = 2304, PC_U = 2816, PC_SV = 3328;
constexpr int MAXROWS = 34816;
constexpr float RMS_EPS = 1e-6f;
constexpr float LOG2E = 1.4426950408889634f;
constexpr float W8_SCALE = 64.0f;
constexpr float A8_SCALE = 8.0f;

constexpr size_t MiB = 1u << 20;
constexpr size_t WS_CTL = 0, CTL_ZERO_BYTES = 1 * MiB;
constexpr size_t WS_WIN = 1 * MiB;
constexpr size_t WS_WIN8 = 31 * MiB;
constexpr size_t WS_X8 = 47 * MiB;
constexpr size_t WS_WBR = 63 * MiB;
constexpr size_t WS_WOUT = 79 * MiB;
constexpr size_t WS_DGU = 87 * MiB;
constexpr size_t WS_DD = 109 * MiB;
constexpr size_t WS_MGU = 120 * MiB;
constexpr size_t WS_MD = 296 * MiB;
constexpr size_t WS_PWT = 384 * MiB;
constexpr size_t WS_SW = 384 * MiB + 512 * 1024;
constexpr size_t WS_X = 385 * MiB;
constexpr size_t WS_XB = 449 * MiB;
constexpr size_t WS_SS = 481 * MiB;
constexpr size_t WS_TOK = 482 * MiB;
constexpr size_t WS_PROJ = 483 * MiB;
constexpr size_t WS_MRG32 = 483 * MiB;
constexpr size_t WS_MRG = 547 * MiB;
constexpr size_t WS_G = 603 * MiB;
constexpr size_t WS_BR = 731 * MiB;
constexpr size_t WS_ACT = 483 * MiB;
constexpr size_t WS_XG = 577 * MiB;
constexpr size_t WS_Y = 738 * MiB;
constexpr size_t WS_END = 806 * MiB;
static_assert(WS_ACT + (size_t)M * FF * 2 <= WS_XG && WS_ACT + (size_t)MAXROWS * FF <= WS_XG && WS_XG + (size_t)8 * 16384 * D <= WS_Y && WS_Y + (size_t)MAXROWS * D * 2 <= WS_END, "ws map");
static_assert(WS_MRG32 + (size_t)M * D * 4 <= WS_MRG && WS_MRG + (size_t)M * D * 2 <= WS_G && WS_PROJ + (size_t)M * PROJ_COLS * 2 <= WS_G, "ws map 2");
constexpr int CW_TMO = 0;
constexpr int CW_BAR = 4096;
constexpr int CW_CNT = 8192;

constexpr int RING_BYTES = 131072;
constexpr int MISC_OFF = RING_BYTES + 320;
constexpr int RSL_OFF = RING_BYTES + 1024;
constexpr int LDS_BYTES = 147456;

#define GAS __attribute__((address_space(1)))
#define LAS __attribute__((address_space(3)))
typedef unsigned short bf16;
typedef unsigned v4u __attribute__((ext_vector_type(4)));
typedef unsigned v2u __attribute__((ext_vector_type(2)));
typedef float f32x4 __attribute__((ext_vector_type(4)));
typedef short bf16x8 __attribute__((ext_vector_type(8)));
typedef short s16x4 __attribute__((ext_vector_type(4)));
#define LDS_WAIT() asm volatile("s_waitcnt lgkmcnt(0)" ::: "memory")
__device__ __forceinline__ float bf2f(unsigned short b) { return __uint_as_float(((unsigned)b) << 16); }
__device__ __forceinline__ float bflo(unsigned w) { return __uint_as_float(w << 16); }
__device__ __forceinline__ float bfhi(unsigned w) { return __uint_as_float(w & 0xffff0000u); }
__device__ __forceinline__ unsigned pk2(float lo, float hi) { return pg8::cvt_pk_bf16(lo, hi); }
__device__ __forceinline__ unsigned pk4_fp8(float a, float b, float c, float d) { int w = 0; w = __builtin_amdgcn_cvt_pk_fp8_f32(a, b, w, false); w = __builtin_amdgcn_cvt_pk_fp8_f32(c, d, w, true); return (unsigned)w; }
__device__ __forceinline__ float fast_sigmoid(float v) { return __builtin_amdgcn_rcpf(1.0f + __builtin_amdgcn_exp2f(-v * LOG2E)); }
#define WS_DPP(x, ctrl, rmask) __int_as_float(__builtin_amdgcn_update_dpp(0, __float_as_int(x), ctrl, rmask, 0xF, false))
__device__ __forceinline__ float rows_sum(float v) {
    { const auto r = __builtin_amdgcn_permlane16_swap(__float_as_uint(v), __float_as_uint(v), false, false); v = __uint_as_float(r[0]) + __uint_as_float(r[1]); }
    { const auto r = __builtin_amdgcn_permlane32_swap(__float_as_uint(v), __float_as_uint(v), false, false); v = __uint_as_float(r[0]) + __uint_as_float(r[1]); }
    return v;
}
__device__ __forceinline__ float rows_max(float v) {
    { const auto r = __builtin_amdgcn_permlane16_swap(__float_as_uint(v), __float_as_uint(v), false, false); v = fmaxf(__uint_as_float(r[0]), __uint_as_float(r[1])); }
    { const auto r = __builtin_amdgcn_permlane32_swap(__float_as_uint(v), __float_as_uint(v), false, false); v = fmaxf(__uint_as_float(r[0]), __uint_as_float(r[1])); }
    return v;
}
__device__ __forceinline__ float wave_sum(float v) {
    v += WS_DPP(v, 0xB1, 0xF);
    v += WS_DPP(v, 0x4E, 0xF);
    v += WS_DPP(v, 0x141, 0xF);
    v += WS_DPP(v, 0x140, 0xF);
    v += WS_DPP(v, 0x142, 0xA);
    v += WS_DPP(v, 0x143, 0xC);
    return __int_as_float(__builtin_amdgcn_readlane(__float_as_int(v), 63));
}

#define XB_TMO      128
#define XB_XCNT(j)  (256  + 64 * (j))
#define XB_XSUB(j)  (1280 + 64 * (j))
#define XB_XGEN(j)  (2304 + 64 * (j))
#define XB_TOP      3328
#define XB_TOPGEN   3392
#define XCD_BAR_WORDS 3456
#define XB_SPIN_CAP (1u << 18)
__device__ __forceinline__ unsigned xb_ld(unsigned* p)              { return __hip_atomic_load(p, __ATOMIC_RELAXED, __HIP_MEMORY_SCOPE_AGENT); }
__device__ __forceinline__ unsigned xb_add(unsigned* p, unsigned v) { return __hip_atomic_fetch_add(p, v, __ATOMIC_RELAXED, __HIP_MEMORY_SCOPE_AGENT); }
__device__ __forceinline__ unsigned xb_xcc_id() { return (unsigned)__builtin_amdgcn_s_getreg((3 << 11) | 20) & 0xFu; }
#define XB_SPIN(cond, bar) do { unsigned _sp = 0; while (cond) { __builtin_amdgcn_s_sleep(1); \
    if ((++_sp & 255u) == 0u) { if (xb_ld(&(bar)[XB_TMO])) break; if (_sp > XB_SPIN_CAP) { atomicAdd(&(bar)[XB_TMO], 1u); break; } } } } while (0)
struct XcdBarrier { unsigned* bar; unsigned x; volatile LAS unsigned* st; };
__device__ __forceinline__ XcdBarrier xcd_barrier_post(unsigned* bar, volatile LAS unsigned* st) {
    XcdBarrier b; b.bar = bar; b.x = xb_xcc_id(); b.st = st;
    if (threadIdx.x == 0) (void)xb_add(&bar[XB_XCNT(b.x)], 1u);
    return b;
}
__device__ __forceinline__ void xcd_barrier_complete(unsigned* bar, unsigned x, unsigned& nloc, unsigned& nx) {
    const unsigned G = gridDim.x * gridDim.y * gridDim.z;
    unsigned sum, cnt, mine, sp = 0u;
    for (;;) {
        sum = 0u; cnt = 0u; mine = 0u;
#pragma unroll
        for (unsigned j = 0; j < 16; ++j) { const unsigned c = xb_ld(&bar[XB_XCNT(j)]); sum += c; cnt += (c > 0u) ? 1u : 0u; mine = (j == x) ? c : mine; }
        if (sum == G) break;
        __builtin_amdgcn_s_sleep(1);
        if ((++sp & 255u) == 0u) { if (xb_ld(&bar[XB_TMO])) break; if (sp > XB_SPIN_CAP) { atomicAdd(&bar[XB_TMO], 1u); break; } }
    }
    nloc = mine > 0u ? mine : 1u; nx = cnt > 0u ? cnt : 1u;
}
__device__ __forceinline__ void xcd_barrier(const XcdBarrier& b) {
    asm volatile("s_waitcnt vmcnt(0)" ::: "memory");
    __syncthreads();
    if (threadIdx.x == 0) {
        unsigned* bar = b.bar;
        __builtin_amdgcn_s_waitcnt(0);
        unsigned nloc = b.st[0], nx = b.st[1];
        if (nloc == 0u) { xcd_barrier_complete(bar, b.x, nloc, nx); b.st[0] = nloc; b.st[1] = nx; }
        const unsigned old = xb_add(&bar[XB_XSUB(b.x)], 1u);
        const unsigned gen = old / nloc;
        if (old + 1u == (gen + 1u) * nloc) {
            __builtin_amdgcn_fence(__ATOMIC_RELEASE, "agent");
            asm volatile("s_waitcnt vmcnt(0)" ::: "memory");
            const unsigned og = xb_add(&bar[XB_TOP], 1u);
            const unsigned tg = og / nx;
            if (og + 1u == (tg + 1u) * nx) xb_add(&bar[XB_TOPGEN], 1u);
            else XB_SPIN(xb_ld(&bar[XB_TOPGEN]) == tg, bar);
            __builtin_amdgcn_fence(__ATOMIC_ACQUIRE, "agent");
            xb_add(&bar[XB_XGEN(b.x)], 1u);
            asm volatile("s_waitcnt vmcnt(0)" ::: "memory");
        } else {
            XB_SPIN(xb_ld(&bar[XB_XGEN(b.x)]) == gen, bar);
            __builtin_amdgcn_fence(__ATOMIC_ACQUIRE, "agent");
            asm volatile("s_waitcnt vmcnt(0)" ::: "memory");
        }
    }
    __syncthreads();
}

using pg8::Unit;
__device__ __forceinline__ float row_rscale(const float* SS, int row) {
    const f32x4 a = *(const f32x4*)(SS + (size_t)row * 4), b = *(const f32x4*)(SS + ((size_t)M + row) * 4), c = *(const f32x4*)(SS + ((size_t)2 * M + row) * 4), d = *(const f32x4*)(SS + ((size_t)3 * M + row) * 4);
    const float s = ((a[0] + a[1]) + (a[2] + a[3])) + ((b[0] + b[1]) + (b[2] + b[3])) + ((c[0] + c[1]) + (c[2] + c[3])) + ((d[0] + d[1]) + (d[2] + d[3]));
    return 1.0f / sqrtf(s * (1.0f / D) + RMS_EPS);
}
__device__ __forceinline__ unsigned gate_frag_off(int pm, int gt, int wave, int am, int lane) { return (unsigned)((((pm * 16 + gt) * 8 + wave) * 8 + am) * 1024 + lane * 16); }
struct EpiG1 {
    __device__ __forceinline__ bool zero_after(const Unit&) const { return true; }
    bf16* PROJ; bf16* G; const float* SS; const LAS float* RSL; int pm0;
    __device__ __forceinline__ void operator()(const f32x4 (&acc)[2][2][4][2], const Unit& u, int wr, int wc, int fr, int fq) const {
        const int row0 = u.pm * 256 + wr * 64 + fr;
        const bool gate = u.pn >= 15;
        float rs[2][4];
        if (u.pm == pm0) {
#pragma unroll
            for (int ai = 0; ai < 2; ++ai)
#pragma unroll
                for (int m = 0; m < 4; ++m) rs[ai][m] = RSL[ai * 128 + wr * 64 + m * 16 + fr];
        } else {
#pragma unroll
            for (int ai = 0; ai < 2; ++ai)
#pragma unroll
                for (int m = 0; m < 4; ++m) rs[ai][m] = row_rscale(SS, row0 + ai * 128 + m * 16);
        }
#pragma unroll
        for (int ai = 0; ai < 2; ++ai)
#pragma unroll
            for (int m = 0; m < 4; ++m) { const int row = row0 + ai * 128 + m * 16; const float r = rs[ai][m];
                if (gate) {
                    unsigned w4[4];
                    const float kr = r * (-LOG2E / W8_SCALE);
#pragma unroll
                    for (int bj = 0; bj < 2; ++bj) { unsigned lo = 0u, hi = 0u;
#define GATE8(x) fmaxf(__builtin_rintf(__builtin_amdgcn_rcpf(__builtin_fmaf(__builtin_amdgcn_exp2f((x) * kr), 1.0f / 255.0f, 1.0f / 255.0f))), 1.0f)
                        lo = __builtin_amdgcn_cvt_pk_u8_f32(GATE8(acc[ai][bj][m][0][0]), 0, lo); lo = __builtin_amdgcn_cvt_pk_u8_f32(GATE8(acc[ai][bj][m][0][1]), 1, lo);
                        lo = __builtin_amdgcn_cvt_pk_u8_f32(GATE8(acc[ai][bj][m][0][2]), 2, lo); lo = __builtin_amdgcn_cvt_pk_u8_f32(GATE8(acc[ai][bj][m][0][3]), 3, lo);
                        hi = __builtin_amdgcn_cvt_pk_u8_f32(GATE8(acc[ai][bj][m][1][0]), 0, hi); hi = __builtin_amdgcn_cvt_pk_u8_f32(GATE8(acc[ai][bj][m][1][1]), 1, hi);
                        hi = __builtin_amdgcn_cvt_pk_u8_f32(GATE8(acc[ai][bj][m][1][2]), 2, hi); hi = __builtin_amdgcn_cvt_pk_u8_f32(GATE8(acc[ai][bj][m][1][3]), 3, hi);
#undef GATE8
                        w4[2 * bj] = lo; w4[2 * bj + 1] = hi; }
                    *(v4u*)((unsigned char*)G + gate_frag_off(u.pm, u.pn - 15, wr * 4 + wc, ai * 4 + m, fq * 16 + fr)) = (v4u){w4[0], w4[1], w4[2], w4[3]};
                } else {
                    bf16* rowp = PROJ + (size_t)row * PROJ_COLS + u.pn * 256 + wc * 32 + 8 * fq;
#pragma unroll
                    for (int bj = 0; bj < 2; ++bj) { const f32x4 v0 = acc[ai][bj][m][0] * r, v1 = acc[ai][bj][m][1] * r;
                        v4u w; w.x = pk2(v0[0], v0[1]); w.y = pk2(v0[2], v0[3]); w.z = pk2(v1[0], v1[1]); w.w = pk2(v1[2], v1[3]);
                        *(v4u*)(rowp + bj * 128) = w; } } }
    }
};
struct EpiB1 {
    const unsigned char* G8; bf16* MRG;
    __device__ __forceinline__ bool zero_after(const Unit& u) const { return (u.pn >> 2) == 3; }
    __device__ __forceinline__ void operator()(f32x4 (&acc)[2][2][4][2], const Unit& u, int wr, int wc, int fr, int fq) const {
        const int n = u.pn >> 2, pn = u.pn & 3, pm = u.pm & 63;
        const int row0 = pm * 256 + wr * 64 + fr, col0 = pn * 256 + wc * 32 + 8 * fq;
        v4u ga[2][4], gb[2][4];
        { const unsigned char* gp = G8 + gate_frag_off(pm, n * 4 + pn, wr * 4 + wc, 0, fq * 16 + fr);
#pragma unroll
          for (int ai = 0; ai < 2; ++ai)
#pragma unroll
            for (int m = 0; m < 4; ++m) { ga[ai][m] = *(const v4u*)(gp + (ai * 4 + m) * 1024); if (n < 3) gb[ai][m] = *(const v4u*)(gp + 4 * 65536 + (ai * 4 + m) * 1024); } }
#pragma unroll
        for (int ai = 0; ai < 2; ++ai) {
#pragma unroll
            for (int m = 0; m < 4; ++m)
#pragma unroll
                for (int bj = 0; bj < 2; ++bj) {
                    float f[8];
#pragma unroll
                    for (int j = 0; j < 8; ++j) { const unsigned wa = bj == 0 ? (j < 4 ? ga[ai][m].x : ga[ai][m].y) : (j < 4 ? ga[ai][m].z : ga[ai][m].w); const float num = (float)((wa >> (8 * (j & 3))) & 0xffu);
                        if (n < 3) { const unsigned wb = bj == 0 ? (j < 4 ? gb[ai][m].x : gb[ai][m].y) : (j < 4 ? gb[ai][m].z : gb[ai][m].w); f[j] = num * __builtin_amdgcn_rcpf((float)((wb >> (8 * (j & 3))) & 0xffu)); }
                        else f[j] = num * (1.0f / 255.0f); }
                    f32x4 v0 = acc[ai][bj][m][0], v1 = acc[ai][bj][m][1];
                    v0[0] *= f[0]; v0[1] *= f[1]; v0[2] *= f[2]; v0[3] *= f[3]; v1[0] *= f[4]; v1[1] *= f[5]; v1[2] *= f[6]; v1[3] *= f[7];
                    if (n < 3) { acc[ai][bj][m][0] = v0; acc[ai][bj][m][1] = v1; }
                    else { v4u w; w.x = pk2(v0[0], v0[1]); w.y = pk2(v0[2], v0[3]); w.z = pk2(v1[0], v1[1]); w.w = pk2(v1[2], v1[3]);
                        *(v4u*)(MRG + (size_t)(row0 + ai * 128 + m * 16) * D + col0 + bj * 128) = w; } }
        }
    }
};
template <bool W8, bool SC8> struct EpiRes {
    __device__ __forceinline__ bool zero_after(const Unit&) const { return true; }
    bf16* XB; float* SS; unsigned char* X8;
    static constexpr float scale = SC8 ? 1.0f / (W8_SCALE * A8_SCALE) : 1.0f;
    __device__ __forceinline__ void operator()(const f32x4 (&acc)[2][2][4][2], const Unit& u, int wr, int wc, int fr, int fq) const {
        const int row0 = u.pm * 256 + wr * 64 + fr, col0 = u.pn * 256 + wc * 32 + 8 * fq;
#pragma unroll
        for (int ai = 0; ai < 2; ++ai) {
            v4u xv[4][2];
#pragma unroll
            for (int m = 0; m < 4; ++m)
#pragma unroll
                for (int bj = 0; bj < 2; ++bj) xv[m][bj] = *(const v4u*)(XB + (size_t)(row0 + ai * 128 + m * 16) * D + col0 + bj * 128);
#pragma unroll
            for (int m = 0; m < 4; ++m) { const int row = row0 + ai * 128 + m * 16; float s = 0.f;
#pragma unroll
                for (int bj = 0; bj < 2; ++bj) { const size_t off = (size_t)row * D + col0 + bj * 128; const v4u xa = xv[m][bj];
                    const f32x4 x0 = (f32x4){bflo(xa.x), bfhi(xa.x), bflo(xa.y), bfhi(xa.y)}, x1 = (f32x4){bflo(xa.z), bfhi(xa.z), bflo(xa.w), bfhi(xa.w)};
                    const f32x4 v0 = x0 + acc[ai][bj][m][0] * scale, v1 = x1 + acc[ai][bj][m][1] * scale;
                    { v4u w; w.x = pk2(v0[0], v0[1]); w.y = pk2(v0[2], v0[3]); w.z = pk2(v1[0], v1[1]); w.w = pk2(v1[2], v1[3]); *(v4u*)(XB + off) = w; }
                    if (W8 && X8) { v2u w8; w8.x = pk4_fp8(v0[0], v0[1], v0[2], v0[3]); w8.y = pk4_fp8(v1[0], v1[1], v1[2], v1[3]); *(v2u*)(X8 + off) = w8; }
                    s += (v0[0] * v0[0] + v0[1] * v0[1]) + (v0[2] * v0[2] + v0[3] * v0[3]) + (v1[0] * v1[0] + v1[1] * v1[1]) + (v1[2] * v1[2] + v1[3] * v1[3]); }
                s = rows_sum(s);
                if (fq == 0) SS[((size_t)u.pn * M + row) * 4 + wc] = s; }
            asm volatile("" ::: "memory");
        }
    }
};
template <bool SCALED> struct EpiGU {
    __device__ __forceinline__ bool zero_after(const Unit&) const { return true; }
    bf16* ACT; const float* SS; const LAS float* RSL; int pm0;
    __device__ __forceinline__ void operator()(const f32x4 (&acc)[2][2][4][2], const Unit& u, int wr, int wc, int fr, int fq) const {
        const int row0 = u.pm * 256 + wr * 64 + fr, col0 = (u.pn % 22) * 128 + wc * 32 + 8 * fq;
#pragma unroll
        for (int ai = 0; ai < 2; ++ai)
#pragma unroll
            for (int m = 0; m < 4; ++m) { if (u.hm == 2 - ai) continue;
                const int row = row0 + ai * 128 + m * 16; const float r = SCALED ? (u.pm == pm0 ? RSL[ai * 128 + wr * 64 + m * 16 + fr] : row_rscale(SS, row)) : 1.0f;
                float o[8];
#pragma unroll
                for (int n = 0; n < 2; ++n)
#pragma unroll
                    for (int j = 0; j < 4; ++j) { const float gt = acc[ai][0][m][n][j] * r, up = acc[ai][1][m][n][j] * r; o[n * 4 + j] = gt * fast_sigmoid(gt) * up; }
                v4u w; w.x = pk2(o[0], o[1]); w.y = pk2(o[2], o[3]); w.z = pk2(o[4], o[5]); w.w = pk2(o[6], o[7]);
                *(v4u*)(ACT + (size_t)row * FF + col0) = w; }
    }
};
struct EpiGU8 {
    __device__ __forceinline__ bool zero_after(const Unit&) const { return true; }
    unsigned char* ACT8; const LAS float* RSL; const float* SS; int pm0;
    __device__ __forceinline__ void operator()(const f32x4 (&acc)[2][2][4][2], const Unit& u, int wr, int wc, int fr, int fq) const {
        const int row0 = u.pm * 256 + wr * 64 + fr, col0 = (u.pn % 22) * 128 + wc * 32 + 8 * fq;
#pragma unroll
        for (int ai = 0; ai < 2; ++ai)
#pragma unroll
            for (int m = 0; m < 4; ++m) { if (u.hm == 2 - ai) continue;
                const int row = row0 + ai * 128 + m * 16; const float r = RSL ? (u.pm == pm0 ? RSL[ai * 128 + wr * 64 + m * 16 + fr] : row_rscale(SS, row)) : 1.0f;
                float o[8];
#pragma unroll
                for (int n = 0; n < 2; ++n)
#pragma unroll
                    for (int j = 0; j < 4; ++j) { const float gt = acc[ai][0][m][n][j] * (r * (1.0f / W8_SCALE)), up = acc[ai][1][m][n][j] * (r * (A8_SCALE / W8_SCALE)); o[n * 4 + j] = gt * fast_sigmoid(gt) * up; }
#pragma unroll
                for (int j = 0; j < 8; ++j) o[j] = __builtin_amdgcn_fmed3f(o[j], -448.0f, 448.0f);
                v2u w; w.x = pk4_fp8(o[0], o[1], o[2], o[3]); w.y = pk4_fp8(o[4], o[5], o[6], o[7]);
                *(v2u*)(ACT8 + (size_t)row * FF + col0) = w; }
    }
};
struct EpiY {
    __device__ __forceinline__ bool zero_after(const Unit&) const { return true; }
    bf16* Y; float scale;
    __device__ __forceinline__ void operator()(const f32x4 (&acc)[2][2][4][2], const Unit& u, int wr, int wc, int fr, int fq) const {
        const int row0 = u.pm * 256 + wr * 64 + fr, col0 = (u.pn & 3) * 256 + wc * 32 + 8 * fq;
#pragma unroll
        for (int ai = 0; ai < 2; ++ai)
#pragma unroll
            for (int m = 0; m < 4; ++m) { if (u.hm == 2 - ai) continue;
                bf16* rowp = Y + (size_t)(row0 + ai * 128 + m * 16) * D + col0;
#pragma unroll
                for (int bj = 0; bj < 2; ++bj) { const f32x4 v0 = acc[ai][bj][m][0] * scale, v1 = acc[ai][bj][m][1] * scale;
                    v4u w; w.x = pk2(v0[0], v0[1]); w.y = pk2(v0[2], v0[3]); w.z = pk2(v1[0], v1[1]); w.w = pk2(v1[2], v1[3]);
                    *(v4u*)(rowp + bj * 128) = w; } }
    }
};
struct B1Order {
    pg8::StaticOrder so;
    __device__ __forceinline__ bool next(int i, Unit& u) const { Unit q; if (!so.next(i >> 2, q)) return false; const int n = i & 3; u.pm = n * 64 + q.pm; u.pn = n * 4 + q.pn; u.pa = u.pm; u.hm = 0; return true; }
};
constexpr int XG_CAP = 16384, XG_CAP_TILES = XG_CAP / 256;
struct SplitOrder {
    pg8::StaticOrder so;
    __device__ __forceinline__ bool next(int i, Unit& u) const { return so.next_split(i, u); }
};
struct MoeOrder {
    pg8::StaticOrder so; int tb1, tb2, tb3, tb4, tb5, tb6, tb7; int nN; int fixedA;
    __device__ __forceinline__ bool next(int i, Unit& u) const { Unit q; if (!so.next_split(i, q)) return false;
        const int e = (q.pm >= tb1) + (q.pm >= tb2) + (q.pm >= tb3) + (q.pm >= tb4) + (q.pm >= tb5) + (q.pm >= tb6) + (q.pm >= tb7);
        int tbe = 0; tbe = e == 1 ? tb1 : tbe; tbe = e == 2 ? tb2 : tbe; tbe = e == 3 ? tb3 : tbe; tbe = e == 4 ? tb4 : tbe; tbe = e == 5 ? tb5 : tbe; tbe = e == 6 ? tb6 : tbe; tbe = e == 7 ? tb7 : tbe;
        u.pm = q.pm; u.pn = e * nN + q.pn; u.pa = fixedA ? e * XG_CAP_TILES + (q.pm - tbe) : q.pm; u.hm = q.hm; return true; }
};

struct Args { const float* in[21]; float* out; unsigned char* ws; int ph_lo, ph_hi; };
static_assert(sizeof(Args) == 21 * 8 + 8 + 8 + 8, "Args has no padding");
enum { IN_X = 0, IN_LNMIX, IN_WIN, IN_SINK, IN_CONVW, IN_POOLW, IN_POOLS, IN_SGUW, IN_SGUB, IN_WBR, IN_WOUT, IN_LNFFN, IN_DG, IN_DU, IN_DD, IN_RW, IN_RB, IN_MG, IN_MU, IN_MD, IN_LNF };
constexpr int PH_PER_LAYER = 9, N_PHASES = 1 + NL * PH_PER_LAYER;

__device__ __forceinline__ size_t btile_off(int drow, int kbyte, int Kbytes) {
    const int pn = drow >> 8, h = (drow >> 7) & 1, g = drow & 127, gl = g & 31;
    const int R = (g & ~31) + 16 * ((gl >> 2) & 1) + 4 * (gl >> 3) + (gl & 3);
    const int kt = kbyte >> 7, cb = kbyte & 127, st = (R >> 4) * 2 + (cb >> 6), ob = (R & 15) * 64 + (cb & 63);
    return ((size_t)((pn * (Kbytes >> 7) + kt) * 2 + h) << 14) + (size_t)(st * 1024 + (ob ^ (((ob >> 9) & 1) << 5)));
}
__device__ __forceinline__ void p0_item(const float* W, int K, int N, int n_lo, int ncols, bf16* WT, const float* gk, int il, int roff, int f8, LAS unsigned char* scr, int item, int lane, bool tm) {
    const int nblk = ncols >> 6, kb = item / nblk, nb = item - kb * nblk, k0 = kb * 64, n0 = nb * 64;
    const int r = lane >> 4, c4 = lane & 15;
    f32x4 v[16];
#pragma unroll
    for (int i = 0; i < 16; ++i) v[i] = *(const f32x4*)(W + (size_t)(k0 + 4 * i + r) * N + n_lo + n0 + 4 * c4);
    if (gk) {
#pragma unroll
        for (int i = 0; i < 16; ++i) v[i] = v[i] * gk[k0 + 4 * i + r]; }
    if (f8) {
#pragma unroll
        for (int i = 0; i < 16; ++i) v[i] = v[i] * W8_SCALE; }
#pragma unroll
    for (int i = 0; i < 16; ++i) { LAS unsigned* d = (LAS unsigned*)(scr + (4 * i + r) * 132 + c4 * 8); d[0] = pk2(v[i][0], v[i][1]); d[1] = pk2(v[i][2], v[i][3]); }
    LDS_WAIT(); asm volatile("" ::: "memory");
    const int c = lane & 7, nr = lane >> 3;
#pragma unroll
    for (int j = 0; j < 8; ++j) { const int n = 8 * j + nr;
        const LAS unsigned short* s = (const LAS unsigned short*)(scr + (8 * c) * 132 + n * 2);
        v4u o; o.x = (unsigned)s[0] | ((unsigned)s[66] << 16); o.y = (unsigned)s[2 * 66] | ((unsigned)s[3 * 66] << 16);
        o.z = (unsigned)s[4 * 66] | ((unsigned)s[5 * 66] << 16); o.w = (unsigned)s[6 * 66] | ((unsigned)s[7 * 66] << 16);
        const int ng = n0 + n; const int drow = il ? ((ng >> 7) * 256 + (ng & 127) + roff) : (ng + roff);
        if (f8) { v2u o8; o8.x = pk4_fp8(bflo(o.x), bfhi(o.x), bflo(o.y), bfhi(o.y)); o8.y = pk4_fp8(bflo(o.z), bfhi(o.z), bflo(o.w), bfhi(o.w));
            *(v2u*)((unsigned char*)WT + btile_off(drow, k0 + 8 * c, K)) = o8; }
        else if (tm) *(v4u*)((unsigned char*)WT + btile_off(drow, (k0 + 8 * c) * 2, K * 2)) = o;
        else *(v4u*)(WT + (size_t)drow * K + k0 + 8 * c) = o; }
    LDS_WAIT(); asm volatile("" ::: "memory");
}
__device__ __forceinline__ void att_unit(LAS unsigned char* lds, const bf16* PROJ, const float* sinks, bf16* BR0, int nb, int kvh) {
    constexpr int KP = 144, VP = 528, VT_OFF = 256 * KP;
    int tid_ = threadIdx.x; asm volatile("" : "+v"(tid_)); const int tid = tid_, lane = tid & 63, wave = __builtin_amdgcn_readfirstlane(tid >> 6);
    const int g4 = wave >> 1, qh = wave & 1, head = kvh * 4 + g4, fr = lane & 15, fg = lane >> 4;
    bf16x8 qfa[4][2];
#pragma unroll
    for (int qt = 0; qt < 4; ++qt) { const bf16* qp = PROJ + (size_t)(nb * 128 + qh * 64 + qt * 16 + fr) * PROJ_COLS + PC_Q + head * 64 + 8 * fg; qfa[qt][0] = *(const bf16x8*)qp; qfa[qt][1] = *(const bf16x8*)(qp + 32); }
    const float sink_t = sinks[head] * LOG2E;
    __syncthreads();
#pragma unroll
    for (int i = 0; i < 4; ++i) { const int q = tid + 512 * i, kj = q >> 3, c = q & 7; const int tk = nb * 128 - 128 + kj;
        v4u kv = (v4u){0u, 0u, 0u, 0u}, vv = (v4u){0u, 0u, 0u, 0u};
        if (tk >= 0) { const bf16* src = PROJ + (size_t)tk * PROJ_COLS + kvh * 64 + c * 8; kv = *(const v4u*)(src + PC_K); vv = *(const v4u*)(src + PC_V); }
        *(LAS v4u*)(lds + kj * KP + c * 16) = kv;
        LAS unsigned short* vt = (LAS unsigned short*)(lds + VT_OFF + (c * 8) * VP + kj * 2);
        vt[0 * (VP / 2)] = (unsigned short)(vv.x & 0xffffu); vt[1 * (VP / 2)] = (unsigned short)(vv.x >> 16);
        vt[2 * (VP / 2)] = (unsigned short)(vv.y & 0xffffu); vt[3 * (VP / 2)] = (unsigned short)(vv.y >> 16);
        vt[4 * (VP / 2)] = (unsigned short)(vv.z & 0xffffu); vt[5 * (VP / 2)] = (unsigned short)(vv.z >> 16);
        vt[6 * (VP / 2)] = (unsigned short)(vv.w & 0xffffu); vt[7 * (VP / 2)] = (unsigned short)(vv.w >> 16); }
    __syncthreads();
#pragma unroll
    for (int qt = 0; qt < 4; ++qt) {
        const int q0 = qh * 64 + qt * 16, qi = q0 + fr, tok = nb * 128 + qi, kb0 = (q0 >> 5);
        const bf16x8 qf0 = qfa[qt][0], qf1 = qfa[qt][1];
        f32x4 sc[5][2];
#pragma unroll
        for (int b = 0; b < 5; ++b)
#pragma unroll
            for (int h2 = 0; h2 < 2; ++h2) { const int key = 32 * (kb0 + b) + 16 * h2 + fr;
                const bf16x8 kf0 = *(const LAS bf16x8*)(lds + key * KP + 16 * fg), kf1 = *(const LAS bf16x8*)(lds + key * KP + 64 + 16 * fg);
                f32x4 s = (f32x4){0.f, 0.f, 0.f, 0.f};
                s = __builtin_amdgcn_mfma_f32_16x16x32_bf16(kf0, qf0, s, 0, 0, 0);
                s = __builtin_amdgcn_mfma_f32_16x16x32_bf16(kf1, qf1, s, 0, 0, 0);
                sc[b][h2] = s; }
        float mx = sink_t;
#pragma unroll
        for (int b = 0; b < 5; ++b)
#pragma unroll
            for (int h2 = 0; h2 < 2; ++h2)
#pragma unroll
                for (int j = 0; j < 4; ++j) { const int kj = 32 * (kb0 + b) + 16 * h2 + 4 * fg + j;
                    const bool valid = (kj > qi) && (kj <= qi + 128) && (nb > 0 || kj >= 128);
                    const float t = valid ? sc[b][h2][j] * (0.125f * LOG2E) : -1e30f; sc[b][h2][j] = t; mx = fmaxf(mx, t); }
        mx = rows_max(mx);
        float sum = 0.f;
#pragma unroll
        for (int b = 0; b < 5; ++b)
#pragma unroll
            for (int h2 = 0; h2 < 2; ++h2)
#pragma unroll
                for (int j = 0; j < 4; ++j) { const float p = __builtin_amdgcn_exp2f(sc[b][h2][j] - mx); sc[b][h2][j] = p; sum += p; }
        sum = rows_sum(sum);
        const float inv = 1.0f / (sum + __builtin_amdgcn_exp2f(sink_t - mx));
        f32x4 o[4];
#pragma unroll
        for (int dt = 0; dt < 4; ++dt) o[dt] = (f32x4){0.f, 0.f, 0.f, 0.f};
#pragma unroll
        for (int b = 0; b < 5; ++b) {
            v4u pw; pw.x = pk2(sc[b][0][0], sc[b][0][1]); pw.y = pk2(sc[b][0][2], sc[b][0][3]); pw.z = pk2(sc[b][1][0], sc[b][1][1]); pw.w = pk2(sc[b][1][2], sc[b][1][3]);
            const bf16x8 pf = __builtin_bit_cast(bf16x8, pw);
#pragma unroll
            for (int dt = 0; dt < 4; ++dt) { const LAS unsigned char* vr = lds + VT_OFF + (16 * dt + fr) * VP + (32 * (kb0 + b) + 4 * fg) * 2;
                const v2u lo = *(const LAS v2u*)vr, hi = *(const LAS v2u*)(vr + 32);
                v4u vw; vw.x = lo.x; vw.y = lo.y; vw.z = hi.x; vw.w = hi.y;
                o[dt] = __builtin_amdgcn_mfma_f32_16x16x32_bf16(__builtin_bit_cast(bf16x8, vw), pf, o[dt], 0, 0, 0); } }
        bf16* op = BR0 + (size_t)tok * 512 + head * 64 + 4 * fg;
#pragma unroll
        for (int dt = 0; dt < 4; ++dt) { v2u w; w.x = pk2(o[dt][0] * inv, o[dt][1] * inv); w.y = pk2(o[dt][2] * inv, o[dt][3] * inv); *(v2u*)(op + 16 * dt) = w; }
    }
}

__device__ __forceinline__ void unpack8(const v4u a, float (&v)[8]) { v[0] = bflo(a.x); v[1] = bfhi(a.x); v[2] = bflo(a.y); v[3] = bfhi(a.y); v[4] = bflo(a.z); v[5] = bfhi(a.z); v[6] = bflo(a.w); v[7] = bfhi(a.w); }
__device__ __forceinline__ void psc_unit(LAS unsigned char* lds, const bf16* PROJ, const float* convw, const bf16* PWT, const float* pscale, const bf16* SW, const float* sgub,
                                         bf16* BR1, bf16* BR2, bf16* BR3, int T, int hf) {
    constexpr int PP = 272;
    constexpr int PL_OFF = 0, PO_OFF = 38912, VT_OFF = 73728;
    int tid_ = threadIdx.x; asm volatile("" : "+v"(tid_)); const int tid = tid_, lane = tid & 63, wave = __builtin_amdgcn_readfirstlane(tid >> 6);
    const int fr = lane & 15, fg = lane >> 4;
    { const int c8 = tid & 31, tr = tid >> 5, ch = hf * 256 + c8 * 8, t0 = T * 128 + tr * 8;
      float w0[8], w1[8], w2[8];
#pragma unroll
      for (int i = 0; i < 8; ++i) { w0[i] = convw[ch + i]; w1[i] = convw[512 + ch + i]; w2[i] = convw[1024 + ch + i]; }
      const bf16* base = PROJ + (size_t)t0 * PROJ_COLS + ch;
      float zm2[8], zm1[8];
      { v4u a2 = (v4u){0u, 0u, 0u, 0u}, b2 = a2, a1 = a2, b1 = a2;
        if (t0 >= 2) { a2 = *(const v4u*)(base - 2 * PROJ_COLS + PC_CC); b2 = *(const v4u*)(base - 2 * PROJ_COLS + PC_CX); a1 = *(const v4u*)(base - PROJ_COLS + PC_CC); b1 = *(const v4u*)(base - PROJ_COLS + PC_CX); }
        float x[8], y[8]; unpack8(a2, x); unpack8(b2, y);
#pragma unroll
        for (int k = 0; k < 8; ++k) zm2[k] = x[k] * y[k];
        unpack8(a1, x); unpack8(b1, y);
#pragma unroll
        for (int k = 0; k < 8; ++k) zm1[k] = x[k] * y[k]; }
#pragma unroll
      for (int h = 0; h < 2; ++h) { v4u ca[4], xa[4], ga[4];
#pragma unroll
          for (int i = 0; i < 4; ++i) { const bf16* p = base + (size_t)(4 * h + i) * PROJ_COLS; ca[i] = *(const v4u*)(p + PC_CC); xa[i] = *(const v4u*)(p + PC_CX); ga[i] = *(const v4u*)(p + PC_CB); }
#pragma unroll
          for (int i = 0; i < 4; ++i) { float z[8], xx[8], gb[8], y[8]; unpack8(ca[i], z); unpack8(xa[i], xx); unpack8(ga[i], gb);
#pragma unroll
              for (int k = 0; k < 8; ++k) { z[k] *= xx[k]; y[k] = gb[k] * (w0[k] * zm2[k] + w1[k] * zm1[k] + w2[k] * z[k]); zm2[k] = zm1[k]; zm1[k] = z[k]; }
              v4u w; w.x = pk2(y[0], y[1]); w.y = pk2(y[2], y[3]); w.z = pk2(y[4], y[5]); w.w = pk2(y[6], y[7]);
              *(v4u*)(BR1 + (size_t)(t0 + 4 * h + i) * 512 + ch) = w; } } }
#pragma unroll 1
    for (int gi = 0; gi < 2; ++gi) {
        const int gp = 2 * hf + gi, win = 2 << gp;
        v4u pl[5], sv[4];
#pragma unroll
        for (int i = 0; i < 5; ++i) { const int q = tid + 512 * i, r = q >> 4, c8 = q & 15, t = T * 128 - 15 + r;
            pl[i] = (v4u){0u, 0u, 0u, 0u};
            if (r < 143 && t >= 0) pl[i] = *(const v4u*)(PROJ + (size_t)t * PROJ_COLS + PC_P + gp * 128 + c8 * 8); }
#pragma unroll
        for (int i = 0; i < 4; ++i) { const int q = tid + 512 * i, s_ = q >> 4, c8 = q & 15; sv[i] = *(const v4u*)(PROJ + (size_t)(T * 128 + s_) * PROJ_COLS + PC_SV + gp * 128 + c8 * 8); }
        bf16x8 pwf[4], wsf[4];
#pragma unroll
        for (int ks = 0; ks < 4; ++ks) { pwf[ks] = *(const bf16x8*)(PWT + (size_t)gp * 16384 + (16 * wave + fr) * 128 + 32 * ks + 8 * fg);
                                         wsf[ks] = *(const bf16x8*)(SW + (size_t)gp * 16384 + (16 * wave + fr) * 128 + 32 * ks + 8 * fg); }
        __syncthreads();
#pragma unroll
        for (int i = 0; i < 5; ++i) { const int q = tid + 512 * i, r = q >> 4, c8 = q & 15; if (r < 143) *(LAS v4u*)(lds + PL_OFF + r * PP + c8 * 16) = pl[i]; }
#pragma unroll
        for (int i = 0; i < 4; ++i) { const int q = tid + 512 * i, s_ = q >> 4, c8 = q & 15; const v4u vv = sv[i];
            LAS unsigned short* vt = (LAS unsigned short*)(lds + VT_OFF + (c8 * 8) * PP + s_ * 2);
            vt[0 * (PP / 2)] = (unsigned short)(vv.x & 0xffffu); vt[1 * (PP / 2)] = (unsigned short)(vv.x >> 16);
            vt[2 * (PP / 2)] = (unsigned short)(vv.y & 0xffffu); vt[3 * (PP / 2)] = (unsigned short)(vv.y >> 16);
            vt[4 * (PP / 2)] = (unsigned short)(vv.z & 0xffffu); vt[5 * (PP / 2)] = (unsigned short)(vv.z >> 16);
            vt[6 * (PP / 2)] = (unsigned short)(vv.w & 0xffffu); vt[7 * (PP / 2)] = (unsigned short)(vv.w >> 16); }
        __syncthreads();
        { const int c8 = tid & 15, tr = tid >> 4; const LAS unsigned char* pcol = lds + PL_OFF + c8 * 16; float s[8];
#pragma unroll
          for (int k = 0; k < 8; ++k) s[k] = 0.f;
          for (int i = 0; i < win; ++i) { float v[8]; unpack8(*(const LAS v4u*)(pcol + (tr * 4 + 15 - i) * PP), v);
#pragma unroll
              for (int k = 0; k < 8; ++k) s[k] += v[k]; }
#pragma unroll
          for (int tt = 0; tt < 4; ++tt) { const int tl = tr * 4 + tt, t = T * 128 + tl; float p0[8]; unpack8(*(const LAS v4u*)(pcol + (tl + 15) * PP), p0);
              if (tt > 0) { float old[8]; unpack8(*(const LAS v4u*)(pcol + (tl + 15 - win) * PP), old);
#pragma unroll
                  for (int k = 0; k < 8; ++k) s[k] += p0[k] - old[k]; }
              const float ic = 1.0f / (float)((t + 1) < win ? (t + 1) : win);
              v4u w; w.x = pk2(s[0] * ic - p0[0], s[1] * ic - p0[1]); w.y = pk2(s[2] * ic - p0[2], s[3] * ic - p0[3]); w.z = pk2(s[4] * ic - p0[4], s[5] * ic - p0[5]); w.w = pk2(s[6] * ic - p0[6], s[7] * ic - p0[7]);
              *(LAS v4u*)(lds + PO_OFF + tl * PP + c8 * 16) = w; } }
        { const int tl = 16 * wave + fr, t = T * 128 + tl; const float bias = sgub[gp * 128 + tl];
          v2u uw[8];
#pragma unroll
          for (int ct = 0; ct < 8; ++ct) uw[ct] = *(const v2u*)(PROJ + (size_t)t * PROJ_COLS + PC_U + gp * 128 + 16 * ct + 4 * fg);
#pragma unroll
          for (int ct = 0; ct < 8; ++ct) { f32x4 a = (f32x4){0.f, 0.f, 0.f, 0.f};
#pragma unroll
              for (int ks = 0; ks < 4; ++ks) { const bf16x8 afr = *(const LAS bf16x8*)(lds + VT_OFF + (16 * ct + fr) * PP + (32 * ks + 8 * fg) * 2);
                  a = __builtin_amdgcn_mfma_f32_16x16x32_bf16(afr, wsf[ks], a, 0, 0, 0); }
              v2u w; w.x = pk2(bflo(uw[ct].x) * (a[0] + bias), bfhi(uw[ct].x) * (a[1] + bias)); w.y = pk2(bflo(uw[ct].y) * (a[2] + bias), bfhi(uw[ct].y) * (a[3] + bias));
              *(v2u*)(BR3 + (size_t)t * 512 + gp * 128 + 16 * ct + 4 * fg) = w; } }
        __syncthreads();
        { const f32x4 ps = *(const f32x4*)(pscale + gp * 128 + 16 * wave + 4 * fg);
#pragma unroll
          for (int tt = 0; tt < 8; ++tt) { f32x4 a = (f32x4){0.f, 0.f, 0.f, 0.f};
#pragma unroll
              for (int ks = 0; ks < 4; ++ks) { const bf16x8 bfr = *(const LAS bf16x8*)(lds + PO_OFF + (16 * tt + fr) * PP + (32 * ks + 8 * fg) * 2);
                  a = __builtin_amdgcn_mfma_f32_16x16x32_bf16(pwf[ks], bfr, a, 0, 0, 0); }
              v2u w; w.x = pk2(a[0] * ps[0], a[1] * ps[1]); w.y = pk2(a[2] * ps[2], a[3] * ps[3]);
              *(v2u*)(BR2 + (size_t)(T * 128 + 16 * tt + fr) * 512 + gp * 128 + 16 * wave + 4 * fg) = w; } }
    }
}

typedef const unsigned char __attribute__((address_space(4)))* kaptr_t;
__device__ __forceinline__ kaptr_t ka_get() { kaptr_t p = (kaptr_t)__builtin_amdgcn_kernarg_segment_ptr(); asm volatile("" : "+s"(p)); return p; }
#define KIN(ka, k) (*(const float* const __attribute__((address_space(4)))*)((ka) + 8 * (k)))
#define KOUT(ka) (*(float* const __attribute__((address_space(4)))*)((ka) + 168))
#define KWS(ka) (*(unsigned char* const __attribute__((address_space(4)))*)((ka) + 176))

__global__ void __launch_bounds__(NWAVES * 64, 2) trunk_fwd(Args args) {
    extern __shared__ __attribute__((aligned(16))) unsigned char lds_raw[];
    LAS unsigned char* lds = (LAS unsigned char*)lds_raw;
    volatile LAS unsigned* MISC = (volatile LAS unsigned*)(lds + MISC_OFF);
    const int G = gridDim.x, bx = blockIdx.x;
    for (int u = threadIdx.x; u < (LDS_BYTES - RING_BYTES) / 4; u += NWAVES * 64) ((LAS unsigned*)(lds + RING_BYTES))[u] = 0u;
    __syncthreads();
    XcdBarrier bar; bar.bar = (unsigned*)(args.ws + WS_CTL) + CW_BAR; bar.x = 0; bar.st = MISC + 8;
    if (!MK_PER_PHASE) bar = xcd_barrier_post((unsigned*)(args.ws + WS_CTL) + CW_BAR, MISC + 8);
    const int lo = args.ph_lo, hi = args.ph_hi;
#define IN(k) (lo <= (k) && (k) < hi)
#define SEAM_IF(c) do { if (c) { if (MK_PER_PHASE) { if (threadIdx.x == 0) __hip_atomic_store((unsigned*)(KWS(ka_get()) + WS_CTL) + CW_TMO, 0xBADBA0u, __ATOMIC_RELAXED, __HIP_MEMORY_SCOPE_AGENT); } \
        else { XcdBarrier b_; b_.bar = (unsigned*)(KWS(ka_get()) + WS_CTL) + CW_BAR; b_.x = xb_xcc_id(); b_.st = MISC + 8; xcd_barrier(b_); } } } while (0)
#define SEAM(k) SEAM_IF((k) + 1 < hi)

    if (IN(0)) {
        kaptr_t ka = ka_get(); unsigned char* ws = KWS(ka);
        const int tid = threadIdx.x, lane = tid & 63, wave = __builtin_amdgcn_readfirstlane(tid >> 6), gw = bx * NWAVES + wave, NGW = G * NWAVES;
        bf16* const WIN_T = (bf16*)(ws + WS_WIN); bf16* const WBR_T = (bf16*)(ws + WS_WBR); bf16* const WOUT_T = (bf16*)(ws + WS_WOUT);
        bf16* const DGU_T = (bf16*)(ws + WS_DGU); bf16* const DD_T = (bf16*)(ws + WS_DD); bf16* const MGU_T = (bf16*)(ws + WS_MGU); bf16* const MD_T = (bf16*)(ws + WS_MD);
        bf16* const PWT = (bf16*)(ws + WS_PWT); bf16* const SW = (bf16*)(ws + WS_SW); bf16* const XB = (bf16*)(ws + WS_XB); float* const SS = (float*)(ws + WS_SS);
        { LAS unsigned char* scr = lds + wave * 8448;
          constexpr int I_WINP = 16 * 60, I_WING = 8 * 64, I_WIN = I_WINP + I_WING, I_WBR = 8 * 16, I_WOUT = 16 * 16, I_FF = 16 * 44, I_FF8 = 8 * 44, I_PW = 4;
          constexpr int S1 = NL * I_WIN, S2 = S1 + NL * 4 * I_WBR, S3 = S2 + NL * I_WOUT, S4 = S3 + 2 * 3 * I_FF, S5 = S4 + (MOE0_F8 ? 0 : NE) * 3 * I_FF, S6 = S5 + (MOE0_F8 ? 2 * NE : NE) * 3 * I_FF8, S7 = S6 + NL * 4 * I_PW;
#pragma unroll 1
          for (int it = gw; it < S7; it += NGW) {
            const float* W; const float* gk = nullptr; bf16* WT; int K, N, il = 0, roff = 0, f8 = 0, item;
            int n_lo = 0, ncols = 0;
            if (it < S1) { const int l = it / I_WIN, r = it - l * I_WIN; W = KIN(ka, IN_WIN) + (size_t)l * D * IN_COLS; K = D; N = IN_COLS; gk = KIN(ka, IN_LNMIX) + l * D;
                if (r < I_WINP) { item = r; ncols = PROJ_COLS; WT = WIN_T + (size_t)l * PROJ_COLS * D; }
                else { item = r - I_WINP; n_lo = PROJ_COLS; ncols = GATE_COLS; f8 = 1; WT = (bf16*)(ws + WS_WIN8 + (size_t)l * GATE_COLS * D); } }
            else if (it < S2) { const int r = it - S1, q = r / I_WBR; item = r - q * I_WBR; W = KIN(ka, IN_WBR) + (size_t)q * 512 * D; K = 512; N = D; WT = WBR_T + (size_t)q * D * 512; }
            else if (it < S3) { const int r = it - S2, l = r / I_WOUT; item = r - l * I_WOUT; W = KIN(ka, IN_WOUT) + (size_t)l * D * D; K = D; N = D; WT = WOUT_T + (size_t)l * D * D; }
            else if (it < S5) { const bool moe = it >= S4; const int r = it - (moe ? S4 : S3), q = r / (3 * I_FF), r2 = r - q * 3 * I_FF, w = r2 / I_FF; item = r2 - w * I_FF;
                const int lay = moe ? 1 : 2 * q;
                if (!moe && ((DENSE_F8_MASK >> q) & 1)) f8 = 2;
                if (w < 2) { W = KIN(ka, moe ? (w ? IN_MU : IN_MG) : (w ? IN_DU : IN_DG)) + (size_t)q * D * FF; K = D; N = FF; WT = (moe ? MGU_T : DGU_T) + (size_t)q * 2 * FF * D; gk = KIN(ka, IN_LNFFN) + lay * D; il = 1; roff = w * 128; }
                else { W = KIN(ka, moe ? IN_MD : IN_DD) + (size_t)q * FF * D; K = FF; N = D; WT = (moe ? MD_T : DD_T) + (size_t)q * D * FF; } }
            else if (it < S6) { const int r = it - S5, q0 = r / (3 * I_FF8), r2 = r - q0 * 3 * I_FF8, w = r2 / I_FF8; item = r2 - w * I_FF8; f8 = 1;
                const int q = MOE0_F8 ? q0 : NE + q0, inst = q >> 3, e = q & 7;
                if (w < 2) { W = KIN(ka, w ? IN_MU : IN_MG) + (size_t)q * D * FF; K = D; N = FF; WT = (bf16*)((unsigned char*)(MGU_T + (size_t)inst * NE * 2 * FF * D) + (size_t)e * 2 * FF * D); gk = KIN(ka, IN_LNFFN) + (2 * inst + 1) * D; il = 1; roff = w * 128; }
                else { W = KIN(ka, IN_MD) + (size_t)q * FF * D; K = FF; N = D; WT = (bf16*)((unsigned char*)(MD_T + (size_t)inst * NE * D * FF) + (size_t)e * D * FF); } }
            else { const int r = it - S6, q = r / I_PW; item = r - q * I_PW; W = KIN(ka, IN_POOLW) + (size_t)q * 16384; K = 128; N = 128; WT = PWT + (size_t)q * 16384; }
            if (ncols == 0) ncols = N;
            if (f8 == 2) { const int nblk = ncols >> 6, kb = item / nblk; if (kb & 1) continue;
                p0_item(W, K, N, n_lo, ncols, WT, gk, il, roff, 1, scr, item, lane, true); item += nblk; f8 = 1; }
            else if (f8) { const int nblk = ncols >> 6, kb2 = item / nblk, nb = item - kb2 * nblk;
                p0_item(W, K, N, n_lo, ncols, WT, gk, il, roff, 1, scr, (2 * kb2) * nblk + nb, lane, true); item = (2 * kb2 + 1) * nblk + nb; }
            p0_item(W, K, N, n_lo, ncols, WT, gk, il, roff, f8, scr, item, lane, it < S6);
          } }
        { const float* sw = KIN(ka, IN_SGUW);
          for (int i = (bx * NWAVES * 64 + tid); i < NL * 4 * 16384 / 4; i += G * NWAVES * 64) { const f32x4 v = *(const f32x4*)(sw + (size_t)i * 4);
            const int e = i * 4, t = (e >> 7) & 127, s = e & 127;
            v2u w; w.x = pk2(s <= t ? v[0] : 0.f, s + 1 <= t ? v[1] : 0.f); w.y = pk2(s + 2 <= t ? v[2] : 0.f, s + 3 <= t ? v[3] : 0.f);
            *(v2u*)(SW + (size_t)e) = w; } }
        { const float* x0 = KIN(ka, IN_X);
#pragma unroll 1
          for (int m0 = gw; m0 < M; m0 += 4 * NGW) {
            f32x4 v[4][4];
#pragma unroll
            for (int q = 0; q < 4; ++q) { const int m = (m0 + q * NGW) < M ? (m0 + q * NGW) : m0; const f32x4* xr = (const f32x4*)(x0 + (size_t)m * D) + lane;
#pragma unroll
                for (int j = 0; j < 4; ++j) v[q][j] = xr[64 * j]; }
#pragma unroll
            for (int q = 0; q < 4; ++q) { const int m = m0 + q * NGW; if (m < M) { float s = 0.f;
#pragma unroll
                for (int j = 0; j < 4; ++j) { const f32x4 w4 = v[q][j]; s += (w4[0] * w4[0] + w4[1] * w4[1]) + (w4[2] * w4[2] + w4[3] * w4[3]);
                    v2u w; w.x = pk2(w4[0], w4[1]); w.y = pk2(w4[2], w4[3]); *((v2u*)(XB + (size_t)m * D) + lane + 64 * j) = w;
                    *((unsigned*)(ws + WS_X8 + (size_t)m * D) + lane + 64 * j) = pk4_fp8(w4[0], w4[1], w4[2], w4[3]); }
                s = wave_sum(s);
                if (lane < 16) SS[((size_t)(lane >> 2) * M + m) * 4 + (lane & 3)] = lane == 0 ? s : 0.f; } } } }
        SEAM(0);
    }

#pragma unroll 1
    for (int l = 0; l < NL; ++l) {
        const int pb = 1 + l * PH_PER_LAYER;
        if (IN(pb + 0)) {
            kaptr_t ka = ka_get(); unsigned char* ws = KWS(ka);
            pg8::StaticOrder S; S.init(M / 256, IN_COLS / 256, G, bx);
            Unit u0; u0.pm = -1; u0.pn = 0; const bool have0 = S.next(0, u0);
            LAS float* RSL = (LAS float*)(lds + RSL_OFF);
            { int t_ = threadIdx.x; asm volatile("" : "+v"(t_)); if (have0 && t_ < 256) RSL[t_] = row_rscale((const float*)(ws + WS_SS), u0.pm * 256 + t_); }
            __syncthreads();
            EpiG1 E{(bf16*)(ws + WS_PROJ), (bf16*)(ws + WS_G), (const float*)(ws + WS_SS), RSL, u0.pm};
            pg8::gemm_phase_mixed(lds, (const bf16*)(ws + WS_XB), (const bf16*)(ws + WS_WIN) + (size_t)l * PROJ_COLS * D, ws + WS_X8, ws + WS_WIN8 + (size_t)l * GATE_COLS * D, PROJ_COLS / 256, S, E);
            SEAM(pb + 0);
        }
        if (IN(pb + 1)) {
            kaptr_t ka = ka_get(); unsigned char* ws = KWS(ka);
            const bf16* PROJ = (const bf16*)(ws + WS_PROJ); bf16* BR = (bf16*)(ws + WS_BR);
            { const float* sinks = KIN(ka, IN_SINK) + l * 8;
              for (int u = bx; u < 256; u += G) att_unit(lds, PROJ, sinks, BR, u >> 1, u & 1); }
            { const float* convw = KIN(ka, IN_CONVW) + l * 1536; const float* pscale = KIN(ka, IN_POOLS) + l * 512; const float* sgub = KIN(ka, IN_SGUB) + l * 512;
              const bf16* PWT = (const bf16*)(ws + WS_PWT) + (size_t)l * 4 * 16384; const bf16* SW = (const bf16*)(ws + WS_SW) + (size_t)l * 4 * 16384;
              for (int u = bx; u < 256; u += G) psc_unit(lds, PROJ, convw, PWT, pscale, SW, sgub, BR + (size_t)M * 512, BR + (size_t)2 * M * 512, BR + (size_t)3 * M * 512, u >> 1, u & 1); }
            __syncthreads();
            SEAM(pb + 1);
        }
        if (IN(pb + 2)) {
            kaptr_t ka = ka_get(); unsigned char* ws = KWS(ka);
            pg8::Gemm g{(const bf16*)(ws + WS_BR), (const bf16*)(ws + WS_WBR) + (size_t)l * 4 * D * 512, 512}; B1Order S; S.so.init(64, 4, G, bx);
            EpiB1 E{(const unsigned char*)(ws + WS_G), (bf16*)(ws + WS_MRG)};
            pg8::gemm_phase<false>(lds, g, S, E);
            SEAM(pb + 2);
        }
        if (IN(pb + 3)) {
            kaptr_t ka = ka_get(); unsigned char* ws = KWS(ka);
            pg8::Gemm g{(const bf16*)(ws + WS_MRG), (const bf16*)(ws + WS_WOUT) + (size_t)l * D * D, D}; pg8::StaticOrder S; S.init(M / 256, D / 256, G, bx);
            EpiRes<DENSE_F8_MASK != 0, false> E{(bf16*)(ws + WS_XB), (float*)(ws + WS_SS), (((l & 1) == 0) && ((DENSE_F8_MASK >> (l >> 1)) & 1)) ? ws + WS_X8 : nullptr};
            pg8::gemm_phase<false>(lds, g, S, E);
            SEAM(pb + 3);
        }
        if ((l & 1) == 0) {
            const int i = l >> 1;
            if (IN(pb + 4)) {
                kaptr_t ka = ka_get(); unsigned char* ws = KWS(ka);
                SplitOrder S; S.so.init(M / 256, 22, G, bx);
                Unit u0; u0.pm = -1; u0.pn = 0; const bool have0 = S.next(0, u0);
                LAS float* RSL = (LAS float*)(lds + RSL_OFF);
                { int t_ = threadIdx.x; asm volatile("" : "+v"(t_)); if (have0 && t_ < 256) RSL[t_] = row_rscale((const float*)(ws + WS_SS), u0.pm * 256 + t_); }
                __syncthreads();
                if ((DENSE_F8_MASK >> i) & 1) { pg8::Gemm g{(const bf16*)(ws + WS_X8), (const bf16*)(ws + WS_DGU) + (size_t)i * 2 * FF * D, D / 2}; EpiGU8 E{ws + WS_ACT, RSL, (const float*)(ws + WS_SS), u0.pm}; pg8::gemm_phase<true>(lds, g, S, E); }
                else { pg8::Gemm g{(const bf16*)(ws + WS_XB), (const bf16*)(ws + WS_DGU) + (size_t)i * 2 * FF * D, D}; EpiGU<true> E{(bf16*)(ws + WS_ACT), (const float*)(ws + WS_SS), RSL, u0.pm}; pg8::gemm_phase<false>(lds, g, S, E); }
                SEAM(pb + 4);
            }
            if (IN(pb + 5)) {
                kaptr_t ka = ka_get(); unsigned char* ws = KWS(ka);
                pg8::StaticOrder S; S.init(M / 256, D / 256, G, bx);
                if ((DENSE_F8_MASK >> i) & 1) { pg8::Gemm g{(const bf16*)(ws + WS_ACT), (const bf16*)(ws + WS_DD) + (size_t)i * D * FF, FF / 2}; EpiRes<true, true> E{(bf16*)(ws + WS_XB), (float*)(ws + WS_SS), ws + WS_X8}; pg8::gemm_phase<true>(lds, g, S, E); }
                else { pg8::Gemm g{(const bf16*)(ws + WS_ACT), (const bf16*)(ws + WS_DD) + (size_t)i * D * FF, FF}; EpiRes<true, false> E{(bf16*)(ws + WS_XB), (float*)(ws + WS_SS), ws + WS_X8}; pg8::gemm_phase<false>(lds, g, S, E); }
                SEAM_IF(pb + 9 < hi);
            }
        } else {
            const int i = l >> 1;
            if (IN(pb + 4)) {
                kaptr_t ka = ka_get(); unsigned char* ws = KWS(ka);
                int tid_ = threadIdx.x; asm volatile("" : "+v"(tid_)); const int tid = tid_, lane = tid & 63, wave = __builtin_amdgcn_readfirstlane(tid >> 6);
                unsigned* CNT = (unsigned*)(ws + WS_CTL) + CW_CNT + i * 64;
                const bf16* XBr = (const bf16*)(ws + WS_XB);
                int* const TOKE = (int*)(ws + WS_TOK); int* const TOKP = TOKE + 2 * M; float* const TOKW = (float*)(TOKP + 2 * M);
                LAS float* WR = (LAS float*)lds;
                LAS int* LE = (LAS int*)(lds + 32768);
                LAS int* LP = (LAS int*)(lds + 33792);
                LAS unsigned char* ROWS = lds + 40960;
                unsigned char* XGF = ws + WS_XG;
                const float* rw = KIN(ka, IN_RW) + (size_t)i * D * NE; const float* gk = KIN(ka, IN_LNFFN) + l * D; const float* rb = KIN(ka, IN_RB) + i * NE;
                __syncthreads();
                { const f32x4* rw4 = (const f32x4*)(rw + (size_t)tid * 16); const f32x4 a0 = rw4[0], a1 = rw4[1], a2 = rw4[2], a3 = rw4[3];
                  const float g0 = gk[2 * tid], g1 = gk[2 * tid + 1];
#pragma unroll
                  for (int e = 0; e < 4; ++e) { WR[e * D + 2 * tid] = a0[e] * g0; WR[(e + 4) * D + 2 * tid] = a1[e] * g0; WR[e * D + 2 * tid + 1] = a2[e] * g1; WR[(e + 4) * D + 2 * tid + 1] = a3[e] * g1; } }
                __syncthreads();
                for (int ch = bx; ch < M / 64; ch += G) {
                    v2u va[8][4];
#pragma unroll
                    for (int ti = 0; ti < 8; ++ti) { const v2u* xr0 = (const v2u*)(XBr + (size_t)(ch * 64 + wave * 8 + ti) * D) + lane;
#pragma unroll
                      for (int j = 0; j < 4; ++j) va[ti][j] = xr0[64 * j]; }
#pragma unroll
                    for (int hb = 0; hb < 2; ++hb) {
                        f32x4 v[4][4]; float s[4], d[4][8];
#pragma unroll
                        for (int q = 0; q < 4; ++q) { s[q] = 0.f;
#pragma unroll
                            for (int j = 0; j < 4; ++j) { const v2u a = va[hb * 4 + q][j]; v[q][j] = (f32x4){bflo(a.x), bfhi(a.x), bflo(a.y), bfhi(a.y)};
                                s[q] += (v[q][j][0] * v[q][j][0] + v[q][j][1] * v[q][j][1]) + (v[q][j][2] * v[q][j][2] + v[q][j][3] * v[q][j][3]); }
#pragma unroll
                            for (int e = 0; e < 8; ++e) d[q][e] = 0.f; }
#pragma unroll
                        for (int e = 0; e < 8; ++e)
#pragma unroll
                            for (int j = 0; j < 4; ++j) { const f32x4 w = *((const LAS f32x4*)(WR + e * D) + lane + 64 * j);
#pragma unroll
                                for (int q = 0; q < 4; ++q) d[q][e] += (v[q][j][0] * w[0] + v[q][j][1] * w[1]) + (v[q][j][2] * w[2] + v[q][j][3] * w[3]); }
#pragma unroll
                        for (int q = 0; q < 4; ++q) { const int tl = wave * 8 + hb * 4 + q, t = ch * 64 + tl;
                            const float r = 1.0f / sqrtf(wave_sum(s[q]) * (1.0f / D) + RMS_EPS);
#pragma unroll
                            for (int j = 0; j < 4; ++j) *((LAS unsigned*)(ROWS + tl * 1024) + lane + 64 * j) = pk4_fp8(v[q][j][0] * r, v[q][j][1] * r, v[q][j][2] * r, v[q][j][3] * r);
                            float lg[8];
#pragma unroll
                            for (int e = 0; e < 8; ++e) lg[e] = wave_sum(d[q][e]) * r + rb[e];
                            int i0 = 0; float v0 = lg[0];
#pragma unroll
                            for (int e = 1; e < 8; ++e) if (lg[e] > v0) { v0 = lg[e]; i0 = e; }
                            int i1 = -1; float v1 = -3.0e38f;
#pragma unroll
                            for (int e = 0; e < 8; ++e) if (e != i0 && lg[e] > v1) { v1 = lg[e]; i1 = e; }
                            const float w1 = 1.0f / (1.0f + __expf(v0 - v1)), w0 = 1.0f - w1;
                            if (lane == 0) { LE[tl * 2] = i0; LE[tl * 2 + 1] = i1; TOKE[t * 2] = i0; TOKE[t * 2 + 1] = i1; TOKW[t * 2] = w0; TOKW[t * 2 + 1] = w1; } } }
                    __syncthreads();
                    if (tid < NE) { const int e = tid; int cnt = 0;
                        for (int q = 0; q < 128; ++q) cnt += (LE[q] == e);
                        int pos = (int)__hip_atomic_fetch_add(CNT + e, (unsigned)cnt, __ATOMIC_RELAXED, __HIP_MEMORY_SCOPE_AGENT);
                        for (int q = 0; q < 128; ++q) if (LE[q] == e) { const int t = ch * 64 + (q >> 1); TOKP[t * 2 + (q & 1)] = pos; LP[q] = pos; ++pos; } }
                    __syncthreads();
#pragma unroll
                    for (int ti = 0; ti < 8; ++ti) { const int tl = wave * 8 + ti; const v4u rowv = *(const LAS v4u*)(ROWS + tl * 1024 + lane * 16);
#pragma unroll
                        for (int k = 0; k < 2; ++k) { const int e = LE[tl * 2 + k], pos = LP[tl * 2 + k]; *(v4u*)(XGF + ((size_t)e * XG_CAP + pos) * D + lane * 16) = rowv; } }
                    __syncthreads();
                }
                SEAM(pb + 4);
            }
            if (IN(pb + 6)) {
                kaptr_t ka = ka_get(); unsigned char* ws = KWS(ka);
                unsigned* CNT = (unsigned*)(ws + WS_CTL) + CW_CNT + i * 64;
                int tb[9]; tb[0] = 0;
#pragma unroll
                for (int e = 0; e < 8; ++e) { const int c = (int)__hip_atomic_load(CNT + e, __ATOMIC_RELAXED, __HIP_MEMORY_SCOPE_AGENT); tb[e + 1] = tb[e] + ((c + 255) >> 8); }
                MoeOrder S; S.so.init(tb[8], 22, G, bx);
                S.tb1 = tb[1]; S.tb2 = tb[2]; S.tb3 = tb[3]; S.tb4 = tb[4]; S.tb5 = tb[5]; S.tb6 = tb[6]; S.tb7 = tb[7]; S.nN = 22; S.fixedA = 1;
                if (i == 0 && !MOE0_F8) { pg8::Gemm g{(const bf16*)(ws + WS_XG), (const bf16*)(ws + WS_MGU), D}; EpiGU<false> E{(bf16*)(ws + WS_ACT), nullptr, nullptr, -1}; pg8::gemm_phase<false>(lds, g, S, E); }
                else { pg8::Gemm g{(const bf16*)(ws + WS_XG), (const bf16*)(ws + WS_MGU) + (size_t)i * NE * 2 * FF * D, D / 2}; EpiGU8 E{ws + WS_ACT, nullptr, nullptr, -1}; pg8::gemm_phase<true>(lds, g, S, E); }
                SEAM(pb + 6);
            }
            if (IN(pb + 7)) {
                kaptr_t ka = ka_get(); unsigned char* ws = KWS(ka);
                unsigned* CNT = (unsigned*)(ws + WS_CTL) + CW_CNT + i * 64;
                int tb[9]; tb[0] = 0;
#pragma unroll
                for (int e = 0; e < 8; ++e) { const int c = (int)__hip_atomic_load(CNT + e, __ATOMIC_RELAXED, __HIP_MEMORY_SCOPE_AGENT); tb[e + 1] = tb[e] + ((c + 255) >> 8); }
                MoeOrder S; S.so.init(tb[8], 4, G, bx);
                S.tb1 = tb[1]; S.tb2 = tb[2]; S.tb3 = tb[3]; S.tb4 = tb[4]; S.tb5 = tb[5]; S.tb6 = tb[6]; S.tb7 = tb[7]; S.nN = 4; S.fixedA = 0;
                if (i == 0 && !MOE0_F8) { pg8::Gemm g{(const bf16*)(ws + WS_ACT), (const bf16*)(ws + WS_MD), FF}; EpiY E{(bf16*)(ws + WS_Y), 1.0f}; pg8::gemm_phase<false>(lds, g, S, E); }
                else { pg8::Gemm g{(const bf16*)(ws + WS_ACT), (const bf16*)(ws + WS_MD) + (size_t)i * NE * D * FF, FF / 2}; EpiY E{(bf16*)(ws + WS_Y), 1.0f / (W8_SCALE * A8_SCALE)}; pg8::gemm_phase<true>(lds, g, S, E); }
                SEAM(pb + 7);
            }
            if (IN(pb + 8)) {
                kaptr_t ka = ka_get(); unsigned char* ws = KWS(ka);
                int tid_ = threadIdx.x; asm volatile("" : "+v"(tid_)); const int tid = tid_, lane = tid & 63, wave = __builtin_amdgcn_readfirstlane(tid >> 6), gw = bx * NWAVES + wave, NGW = G * NWAVES;
                unsigned* CNT = (unsigned*)(ws + WS_CTL) + CW_CNT + i * 64;
                int tb[9]; tb[0] = 0;
#pragma unroll
                for (int e = 0; e < 8; ++e) { const int c = (int)__hip_atomic_load(CNT + e, __ATOMIC_RELAXED, __HIP_MEMORY_SCOPE_AGENT); tb[e + 1] = tb[e] + ((c + 255) >> 8); }
                bf16* XB = (bf16*)(ws + WS_XB); float* SS = (float*)(ws + WS_SS); const bf16* Y = (const bf16*)(ws + WS_Y);
                const int* TOKE = (const int*)(ws + WS_TOK); const int* TOKP = TOKE + 2 * M; const float* TOKW = (const float*)(TOKP + 2 * M);
                const bool last = (l == NL - 1);
                const float* gfin = KIN(ka, IN_LNF); float* outp = KOUT(ka);
#pragma unroll 1
                for (int t0 = gw; t0 < M; t0 += 4 * NGW) {
                    int ek[4][2], pk[4][2]; float wk[4][2];
#pragma unroll
                    for (int q = 0; q < 4; ++q) { const int t = (t0 + q * NGW) < M ? (t0 + q * NGW) : t0;
#pragma unroll
                        for (int k = 0; k < 2; ++k) { ek[q][k] = TOKE[t * 2 + k]; pk[q][k] = TOKP[t * 2 + k]; wk[q][k] = TOKW[t * 2 + k]; } }
                    v2u xv[4][4], ya[4][4], yb[4][4];
#pragma unroll
                    for (int q = 0; q < 4; ++q) { const int t = (t0 + q * NGW) < M ? (t0 + q * NGW) : t0;
                        const int e0 = __builtin_amdgcn_readfirstlane(ek[q][0]), e1 = __builtin_amdgcn_readfirstlane(ek[q][1]), p0 = __builtin_amdgcn_readfirstlane(pk[q][0]), p1 = __builtin_amdgcn_readfirstlane(pk[q][1]);
                        int b0 = 0, b1 = 0;
#pragma unroll
                        for (int qq = 1; qq < 8; ++qq) { b0 = (e0 == qq) ? tb[qq] : b0; b1 = (e1 == qq) ? tb[qq] : b1; }
                        const v2u* y0 = (const v2u*)(Y + (size_t)(b0 * 256 + p0) * D) + lane; const v2u* y1 = (const v2u*)(Y + (size_t)(b1 * 256 + p1) * D) + lane;
                        const v2u* xr = (const v2u*)(XB + (size_t)t * D) + lane;
#pragma unroll
                        for (int j = 0; j < 4; ++j) { xv[q][j] = xr[64 * j]; ya[q][j] = y0[64 * j]; yb[q][j] = y1[64 * j]; } }
#pragma unroll
                    for (int q = 0; q < 4; ++q) { const int t = t0 + q * NGW; if (t < M) { const float w0 = wk[q][0], w1 = wk[q][1];
                        f32x4 v[4]; float s = 0.f;
#pragma unroll
                        for (int j = 0; j < 4; ++j) { const v2u a = ya[q][j], b = yb[q][j]; f32x4 x = (f32x4){bflo(xv[q][j].x), bfhi(xv[q][j].x), bflo(xv[q][j].y), bfhi(xv[q][j].y)};
                            x[0] += w0 * bflo(a.x) + w1 * bflo(b.x); x[1] += w0 * bfhi(a.x) + w1 * bfhi(b.x); x[2] += w0 * bflo(a.y) + w1 * bflo(b.y); x[3] += w0 * bfhi(a.y) + w1 * bfhi(b.y);
                            v[j] = x; s += (x[0] * x[0] + x[1] * x[1]) + (x[2] * x[2] + x[3] * x[3]); }
                        s = wave_sum(s);
                        if (!last) {
#pragma unroll
                            for (int j = 0; j < 4; ++j) { v2u w; w.x = pk2(v[j][0], v[j][1]); w.y = pk2(v[j][2], v[j][3]); *((v2u*)(XB + (size_t)t * D) + lane + 64 * j) = w;
                                *((unsigned*)(ws + WS_X8 + (size_t)t * D) + lane + 64 * j) = pk4_fp8(v[j][0], v[j][1], v[j][2], v[j][3]); }
                            if (lane < 16) SS[((size_t)(lane >> 2) * M + t) * 4 + (lane & 3)] = lane == 0 ? s : 0.f;
                        } else {
                            const float r = 1.0f / sqrtf(s * (1.0f / D) + RMS_EPS);
                            const f32x4* gf = (const f32x4*)gfin + lane; f32x4* orow = (f32x4*)(outp + (size_t)t * D) + lane;
#pragma unroll
                            for (int j = 0; j < 4; ++j) orow[64 * j] = v[j] * r * gf[64 * j];
                        } } }
                }
                SEAM(pb + 8);
            }
        }
    }
#undef IN
#undef SEAM
#undef SEAM_IF
}

extern "C" void kernel_launch(void* const* d_in, const int* in_sizes, int n_in, void* d_out, int out_size, void* d_ws, size_t ws_size, hipStream_t stream) {
    static int grid = 0;
    if (grid == 0) {
        if (n_in != 21 || in_sizes[0] != M * D || out_size != M * D || ws_size < WS_END) { fprintf(stderr, "kernel_launch: unexpected shapes / workspace (%zu < %zu)\n", ws_size, (size_t)WS_END); grid = -1; return; }
        int dev = 0, cus = 0, per_cu = 0;
        if (hipGetDevice(&dev) != hipSuccess || hipDeviceGetAttribute(&cus, hipDeviceAttributeMultiprocessorCount, dev) != hipSuccess) { grid = -1; return; }
        if (hipFuncSetAttribute((const void*)trunk_fwd, hipFuncAttributeMaxDynamicSharedMemorySize, LDS_BYTES) != hipSuccess) { fprintf(stderr, "kernel_launch: hipFuncSetAttribute failed\n"); grid = -1; return; }
        if (hipOccupancyMaxActiveBlocksPerMultiprocessor(&per_cu, (const void*)trunk_fwd, NWAVES * 64, LDS_BYTES) != hipSuccess || per_cu < 1) { fprintf(stderr, "kernel_launch: occupancy query says %d\n", per_cu); (void)hipGetLastError(); grid = -1; return; }
        grid = cus;
    }
    if (grid < 0) return;
    if (hipMemsetAsync((char*)d_ws + WS_CTL, 0, CTL_ZERO_BYTES, stream) != hipSuccess) return;
    Args a{};
    for (int i = 0; i < 21; ++i) a.in[i] = (const float*)d_in[i];
    a.out = (float*)d_out; a.ws = (unsigned char*)d_ws;
#if MK_PER_PHASE
    for (int p = 0; p < N_PHASES; ++p) {
        if (p >= 1) { const int l = (p - 1) / PH_PER_LAYER, k = (p - 1) % PH_PER_LAYER; if ((l & 1) == 0 && k >= 6) continue; }
        a.ph_lo = p; a.ph_hi = p + 1;
        hipLaunchKernelGGL(trunk_fwd, dim3(grid), dim3(NWAVES * 64), LDS_BYTES, stream, a);
    }
#else
    a.ph_lo = 0; a.ph_hi = N_PHASES;
    hipLaunchKernelGGL(trunk_fwd, dim3(grid), dim3(NWAVES * 64), LDS_BYTES, stream, a);
#endif
}
```

```cpp
#include <hip/hip_runtime.h>
#include <cstdio>
#include <cstdint>

#define MOE0_F8 1
#define DENSE_F8_MASK 2
#ifndef MK_PER_PHASE
#define MK_PER_PHASE 0
#endif

namespace pg8 {
#define PG8_LAS __attribute__((address_space(3)))
typedef unsigned short bf16_t;
typedef short bf16x8 __attribute__((ext_vector_type(8)));
typedef float f32x4 __attribute__((ext_vector_type(4)));
typedef unsigned u32x4 __attribute__((ext_vector_type(4)));
typedef unsigned u32x2 __attribute__((ext_vector_type(2)));
constexpr int BM = 256, BK = 64, HALF = 128, HTB = HALF * BK * 2, STAGE_BYTES = 8 * HTB, NXCD = 8, WGM = 8;

__host__ __device__ __forceinline__ int lds_byte(int r, int c) { const int st = (r >> 4) * 2 + (c >> 5), rr = r & 15, cc = c & 31, ob = rr * 64 + cc * 2; return st * 1024 + (ob ^ (((ob >> 9) & 1) << 5)); }
__host__ __device__ __forceinline__ void stage_rc(int b, int& R, int& C) { const int st = b / 1024, sb = b % 1024, swz = sb ^ (((sb >> 9) & 1) << 5); R = (st >> 1) * 16 + swz / 64; C = (st & 1) * 32 + (swz % 64) / 2; }
__host__ __device__ __forceinline__ int perm32(int rho) { const int n = rho >> 4, i = rho & 15; return 8 * (i >> 2) + 4 * n + (i & 3); }

struct Unit { int pm, pn, pa; };
struct Gemm { const bf16_t* A; const bf16_t* Bt; int K; };

struct StaticOrder {
    int nM, nN, nwg, G, c;
    __host__ __device__ __forceinline__ void init(int nM_, int nN_, int G_, int c_) { nM = nM_; nN = nN_; nwg = nM * nN; G = G_; c = c_; }
    __host__ __device__ __forceinline__ bool next(int i, Unit& u) const {
        const long L = (long)i * G + c; if (L >= nwg) return false;
        int wgid = (int)L; { const int q = nwg / NXCD, r = nwg % NXCD, xcd = wgid % NXCD, off = wgid / NXCD; wgid = (xcd < r ? xcd * (q + 1) : r * (q + 1) + (xcd - r) * q) + off; }
        const int nig = WGM * nN, gid = wgid / nig, fm = gid * WGM, gsz = (nM - fm) < WGM ? (nM - fm) : WGM;
        u.pm = fm + ((wgid % nig) % gsz); u.pn = (wgid % nig) / gsz; u.pa = u.pm; return true;
    }
};

__device__ __forceinline__ unsigned cvt_pk_bf16(float lo, float hi) { unsigned r; asm volatile("v_cvt_pk_bf16_f32 %0, %1, %2" : "=v"(r) : "v"(lo), "v"(hi)); return r; }

typedef int i32x4 __attribute__((ext_vector_type(4)));
typedef int i32x8 __attribute__((ext_vector_type(8)));
template <bool F8, class Epi, class Sched>
__device__ __forceinline__ void gemm_phase(PG8_LAS unsigned char* lds, const Gemm g, const Sched& S, const Epi& E) {
    int tid_ = threadIdx.x; asm volatile("" : "+v"(tid_));
    const int tid = tid_, wid = __builtin_amdgcn_readfirstlane(tid >> 6), lane = tid & 63, wr = wid >> 2, wc = wid & 3, fr = lane & 15, fq = lane >> 4;
    int K_ = g.K; asm volatile("" : "+s"(K_));
    const int K = K_, nt = K / BK;
    unsigned voffA[2], voffB[2];
#pragma unroll
    for (int i = 0; i < 2; ++i) { int R, C; stage_rc(tid * 16 + i * 8192, R, C);
        voffA[i] = (unsigned)(R * K + C) * 2u; voffB[i] = (unsigned)(tid * 16 + i * 8192); }
    const size_t kstep = (size_t)(BK * 2);
    const size_t hstep = (size_t)HALF * K * 2;
    const size_t tstep = 2 * hstep;
    const size_t kstepB = 2 * HTB, hstepB = HTB;
    const unsigned ldsw = (unsigned)wid * 1024u;
    const int aoff = lds_byte(wr * 64 + fr, fq * 8), boff = lds_byte(wc * 32 + fr, fq * 8);
#define PG8_SA(b, h) (((b) * 2 + (h)) * HTB)
#define PG8_SB(b, h) ((4 + (b) * 2 + (h)) * HTB)
#define PG8_STAGE(bufoff, gbase, voff) do { _Pragma("unroll") for (int _i = 0; _i < 2; ++_i) \
        __builtin_amdgcn_global_load_lds((const unsigned*)((const char*)(gbase) + (voff)[_i]), (PG8_LAS unsigned*)(lds + (bufoff) + ldsw + _i * 8192), 16, 0, 0); } while (0)
#define PG8_LDA(dst, b, h) do { _Pragma("unroll") for (int m = 0; m < 4; ++m) { const bf16x8 x0_ = *(const PG8_LAS bf16x8*)(lds + PG8_SA(b, h) + aoff + m * 2048), x1_ = *(const PG8_LAS bf16x8*)(lds + PG8_SA(b, h) + aoff + m * 2048 + 1024); \
        if constexpr (F8) dst##8[m] = PG8_CAT(x0_, x1_); else { dst[m][0] = x0_; dst[m][1] = x1_; } } } while (0)
#define PG8_LDB(dst, b, h) do { _Pragma("unroll") for (int n = 0; n < 2; ++n) { const bf16x8 x0_ = *(const PG8_LAS bf16x8*)(lds + PG8_SB(b, h) + boff + n * 2048), x1_ = *(const PG8_LAS bf16x8*)(lds + PG8_SB(b, h) + boff + n * 2048 + 1024); \
        if constexpr (F8) dst##8[n] = PG8_CAT(x0_, x1_); else { dst[n][0] = x0_; dst[n][1] = x1_; } } } while (0)
#define PG8_CAT(x0, x1) __builtin_shufflevector(__builtin_bit_cast(i32x4, x0), __builtin_bit_cast(i32x4, x1), 0, 1, 2, 3, 4, 5, 6, 7)
#define PG8_MMA(ai, bj, At, Bt) do { __builtin_amdgcn_s_setprio(1); \
        if constexpr (F8) { _Pragma("unroll") for (int m = 0; m < 4; ++m) _Pragma("unroll") for (int n = 0; n < 2; ++n) \
            asm volatile("v_mfma_f32_16x16x128_f8f6f4 %0, %1, %2, %0" : "+v"(acc[ai][bj][m][n]) : "v"(Bt##8[n]), "v"(At##8[m])); } \
        else { _Pragma("unroll") for (int m = 0; m < 4; ++m) _Pragma("unroll") for (int n = 0; n < 2; ++n) _Pragma("unroll") for (int k = 0; k < 2; ++k) \
            acc[ai][bj][m][n] = __builtin_amdgcn_mfma_f32_16x16x32_bf16(Bt[n][k], At[m][k], acc[ai][bj][m][n], 0, 0, 0); } \
        __builtin_amdgcn_s_setprio(0); } while (0)
#define PG8_WAIT_V(n) asm volatile("s_waitcnt vmcnt(" #n ")" ::: "memory")
#define PG8_WAIT_L(n) asm volatile("s_waitcnt lgkmcnt(" #n ")" ::: "memory")
#define PG8_BAR __builtin_amdgcn_s_barrier()
#define PG8_SCHED __builtin_amdgcn_sched_barrier(0)
    Unit cur, nxt; int ui = 0;
    if (!S.next(0, cur)) return;
    f32x4 acc[2][2][4][2];
#pragma unroll
    for (int a = 0; a < 2; ++a)
#pragma unroll
        for (int b = 0; b < 2; ++b)
#pragma unroll
            for (int m = 0; m < 4; ++m)
#pragma unroll
                for (int n = 0; n < 2; ++n) acc[a][b][m][n] = (f32x4){0.f, 0.f, 0.f, 0.f};
    bf16x8 At[4][2], B0[2][2], B1[2][2]; i32x8 At8[4], B08[2], B18[2];
    const char* cA = (const char*)g.A + (size_t)cur.pa * tstep; const char* cB = (const char*)g.Bt + (size_t)cur.pn * tstep;
    PG8_STAGE(PG8_SB(0, 0), cB, voffB); PG8_STAGE(PG8_SB(0, 1), cB + hstepB, voffB); PG8_STAGE(PG8_SA(0, 0), cA, voffA); PG8_STAGE(PG8_SA(0, 1), cA + hstep, voffA);
    if (wr == 1) PG8_BAR;
    PG8_WAIT_V(2); PG8_BAR;
    PG8_STAGE(PG8_SB(1, 0), cB + kstepB, voffB); PG8_STAGE(PG8_SA(1, 0), cA + kstep, voffA); PG8_STAGE(PG8_SB(1, 1), cB + hstepB + kstepB, voffB);
    PG8_WAIT_V(6); PG8_BAR;
    for (;;) {
        const bool has_next = S.next(ui + 1, nxt);
        const char* nA = has_next ? (const char*)g.A + (size_t)nxt.pa * tstep : cA; const char* nB = has_next ? (const char*)g.Bt + (size_t)nxt.pn * tstep : cB;
#pragma clang loop unroll(disable)
        for (int t = 0; t < nt; t += 2) {
            const bool last = (t == nt - 2);
            const char* a1 = cA + (size_t)(t + 1) * kstep;
            const char* a2 = last ? nA : cA + (size_t)(t + 2) * kstep; const char* b2 = last ? nB : cB + (size_t)(t + 2) * kstepB;
            const char* a3 = a2 + kstep; const char* b3 = b2 + kstepB;
            PG8_LDB(B0, 0, 0); PG8_LDB(B1, 0, 1); PG8_SCHED; PG8_LDA(At, 0, 0); PG8_STAGE(PG8_SA(1, 1), a1 + hstep, voffA);
            PG8_WAIT_V(8); PG8_WAIT_L(0); PG8_BAR; PG8_MMA(0, 0, At, B0); PG8_MMA(0, 1, At, B1); PG8_BAR; PG8_SCHED;
            PG8_LDA(At, 0, 1); PG8_STAGE(PG8_SB(0, 0), b2, voffB); PG8_STAGE(PG8_SB(0, 1), b2 + hstepB, voffB); PG8_STAGE(PG8_SA(0, 0), a2, voffA);
            PG8_WAIT_V(8); PG8_WAIT_L(0); PG8_BAR; PG8_MMA(1, 0, At, B0); PG8_MMA(1, 1, At, B1); PG8_BAR; PG8_SCHED;
            PG8_LDB(B0, 1, 0); PG8_LDB(B1, 1, 1); PG8_SCHED; PG8_LDA(At, 1, 0); PG8_STAGE(PG8_SA(0, 1), a2 + hstep, voffA);
            PG8_WAIT_V(8); PG8_WAIT_L(0); PG8_BAR; PG8_MMA(0, 0, At, B0); PG8_MMA(0, 1, At, B1); PG8_BAR; PG8_SCHED;
            PG8_LDA(At, 1, 1); PG8_STAGE(PG8_SB(1, 0), b3, voffB); PG8_STAGE(PG8_SB(1, 1), b3 + hstepB, voffB); PG8_STAGE(PG8_SA(1, 0), a3, voffA);
            PG8_WAIT_V(8); PG8_WAIT_L(0); PG8_BAR; PG8_MMA(1, 0, At, B0); PG8_MMA(1, 1, At, B1); PG8_BAR; PG8_SCHED;
        }
        if (wr == 0) PG8_BAR;
        if constexpr (F8) asm volatile("s_nop 15\n\ts_nop 15" ::: "memory");
        E(acc, cur, wr, wc, fr, fq);
        if (!has_next) break;
        if (E.zero_after(cur)) {
#pragma unroll
        for (int a = 0; a < 2; ++a)
#pragma unroll
            for (int b = 0; b < 2; ++b)
#pragma unroll
                for (int m = 0; m < 4; ++m)
#pragma unroll
                    for (int n = 0; n < 2; ++n) acc[a][b][m][n] = (f32x4){0.f, 0.f, 0.f, 0.f};
        }
        cur = nxt; cA = nA; cB = nB; ++ui;
        if (wr == 1) PG8_BAR;
    }
    PG8_WAIT_V(0);
    PG8_BAR;
#undef PG8_SA
#undef PG8_SB
#undef PG8_STAGE
#undef PG8_LDA
#undef PG8_LDB
#undef PG8_MMA
#undef PG8_CAT
#undef PG8_WAIT_V
#undef PG8_WAIT_L
#undef PG8_BAR
#undef PG8_SCHED
}

template <class Epi, class Sched>
__device__ __forceinline__ void gemm_phase_mixed(PG8_LAS unsigned char* lds, const bf16_t* A16, const bf16_t* B16, const unsigned char* A8, const unsigned char* B8, int nproj, const Sched& S, const Epi& E) {
    int tid_ = threadIdx.x; asm volatile("" : "+v"(tid_));
    const int tid = tid_, wid = __builtin_amdgcn_readfirstlane(tid >> 6), lane = tid & 63, wr = wid >> 2, wc = wid & 3, fr = lane & 15, fq = lane >> 4;
    int K_ = 1024; asm volatile("" : "+s"(K_));
    const int K = K_;
    unsigned voffA[2], voffB[2];
#pragma unroll
    for (int i = 0; i < 2; ++i) { int R, C; stage_rc(tid * 16 + i * 8192, R, C);
        voffA[i] = (unsigned)(R * K + C) * 2u; voffB[i] = (unsigned)(tid * 16 + i * 8192); }
    const size_t kstep = (size_t)(BK * 2);
    const size_t hstep16 = (size_t)HALF * K * 2, hstep8 = hstep16 >> 1;
    const size_t kstepB = 2 * HTB, hstepB = HTB;
    const unsigned ldsw = (unsigned)wid * 1024u;
    const int aoff = lds_byte(wr * 64 + fr, fq * 8), boff = lds_byte(wc * 32 + fr, fq * 8);
#define PG8_SA(b, h) (((b) * 2 + (h)) * HTB)
#define PG8_SB(b, h) ((4 + (b) * 2 + (h)) * HTB)
#define MX_OFF(v, f8) ((f8) ? (((v) >> 1) + (((v) & 127u) >> 1)) : (v))
#define PG8_STAGE(bufoff, gbase, voff, f8) do { _Pragma("unroll") for (int _i = 0; _i < 2; ++_i) \
        __builtin_amdgcn_global_load_lds((const unsigned*)((const char*)(gbase) + MX_OFF((voff)[_i], f8)), (PG8_LAS unsigned*)(lds + (bufoff) + ldsw + _i * 8192), 16, 0, 0); } while (0)
#define PG8_CAT(x0, x1) __builtin_shufflevector(__builtin_bit_cast(i32x4, x0), __builtin_bit_cast(i32x4, x1), 0, 1, 2, 3, 4, 5, 6, 7)
#define PG8_LDA(F8K, dst, b, h) do { _Pragma("unroll") for (int m = 0; m < 4; ++m) { const bf16x8 x0_ = *(const PG8_LAS bf16x8*)(lds + PG8_SA(b, h) + aoff + m * 2048), x1_ = *(const PG8_LAS bf16x8*)(lds + PG8_SA(b, h) + aoff + m * 2048 + 1024); \
        if constexpr (F8K) dst##8[m] = PG8_CAT(x0_, x1_); else { dst[m][0] = x0_; dst[m][1] = x1_; } } } while (0)
#define PG8_LDB(F8K, dst, b, h) do { _Pragma("unroll") for (int n = 0; n < 2; ++n) { const bf16x8 x0_ = *(const PG8_LAS bf16x8*)(lds + PG8_SB(b, h) + boff + n * 2048), x1_ = *(const PG8_LAS bf16x8*)(lds + PG8_SB(b, h) + boff + n * 2048 + 1024); \
        if constexpr (F8K) dst##8[n] = PG8_CAT(x0_, x1_); else { dst[n][0] = x0_; dst[n][1] = x1_; } } } while (0)
#define PG8_MMA(F8K, ai, bj, At, Bt) do { __builtin_amdgcn_s_setprio(1); \
        if constexpr (F8K) { _Pragma("unroll") for (int m = 0; m < 4; ++m) _Pragma("unroll") for (int n = 0; n < 2; ++n) \
            asm volatile("v_mfma_f32_16x16x128_f8f6f4 %0, %1, %2, %0" : "+v"(acc[ai][bj][m][n]) : "v"(Bt##8[n]), "v"(At##8[m])); } \
        else { _Pragma("unroll") for (int m = 0; m < 4; ++m) _Pragma("unroll") for (int n = 0; n < 2; ++n) _Pragma("unroll") for (int k = 0; k < 2; ++k) \
            acc[ai][bj][m][n] = __builtin_amdgcn_mfma_f32_16x16x32_bf16(Bt[n][k], At[m][k], acc[ai][bj][m][n], 0, 0, 0); } \
        __builtin_amdgcn_s_setprio(0); } while (0)
#define PG8_WAIT_V(n) asm volatile("s_waitcnt vmcnt(" #n ")" ::: "memory")
#define PG8_WAIT_L(n) asm volatile("s_waitcnt lgkmcnt(" #n ")" ::: "memory")
#define PG8_BAR __builtin_amdgcn_s_barrier()
#define PG8_SCHED __builtin_amdgcn_sched_barrier(0)
#define MX_UNIT(u, f8, pa, pb, hs, ntv) do { f8 = (u).pn >= nproj; \
        pa = f8 ? (const char*)A8 + (size_t)(u).pm * (2 * hstep8) : (const char*)A16 + (size_t)(u).pm * (2 * hstep16); \
        pb = f8 ? (const char*)B8 + (size_t)((u).pn - nproj) * (2 * hstep8) : (const char*)B16 + (size_t)(u).pn * (2 * hstep16); \
        hs = f8 ? hstep8 : hstep16; ntv = f8 ? (K >> 7) : (K >> 6); } while (0)
#define MX_KLOOP(F8K) _Pragma("clang loop unroll(disable)") \
        for (int t = 0; t < cnt; t += 2) { \
            const bool last = (t == cnt - 2); \
            const char* a1 = cA + (size_t)(t + 1) * kstep; \
            const bool f2 = last ? nF8 : cF8; const size_t hs2 = last ? nhs : chs; \
            const char* a2 = last ? nA : cA + (size_t)(t + 2) * kstep; const char* b2 = last ? nB : cB + (size_t)(t + 2) * kstepB; \
            const char* a3 = a2 + kstep; const char* b3 = b2 + kstepB; \
            PG8_LDB(F8K, B0, 0, 0); PG8_LDB(F8K, B1, 0, 1); PG8_SCHED; PG8_LDA(F8K, At, 0, 0); PG8_STAGE(PG8_SA(1, 1), a1 + chs, voffA, cF8); \
            PG8_WAIT_V(8); PG8_WAIT_L(0); PG8_BAR; PG8_MMA(F8K, 0, 0, At, B0); PG8_MMA(F8K, 0, 1, At, B1); PG8_BAR; PG8_SCHED; \
            PG8_LDA(F8K, At, 0, 1); PG8_STAGE(PG8_SB(0, 0), b2, voffB, false); PG8_STAGE(PG8_SB(0, 1), b2 + hstepB, voffB, false); PG8_STAGE(PG8_SA(0, 0), a2, voffA, f2); \
            PG8_WAIT_V(8); PG8_WAIT_L(0); PG8_BAR; PG8_MMA(F8K, 1, 0, At, B0); PG8_MMA(F8K, 1, 1, At, B1); PG8_BAR; PG8_SCHED; \
            PG8_LDB(F8K, B0, 1, 0); PG8_LDB(F8K, B1, 1, 1); PG8_SCHED; PG8_LDA(F8K, At, 1, 0); PG8_STAGE(PG8_SA(0, 1), a2 + hs2, voffA, f2); \
            PG8_WAIT_V(8); PG8_WAIT_L(0); PG8_BAR; PG8_MMA(F8K, 0, 0, At, B0); PG8_MMA(F8K, 0, 1, At, B1); PG8_BAR; PG8_SCHED; \
            PG8_LDA(F8K, At, 1, 1); PG8_STAGE(PG8_SB(1, 0), b3, voffB, false); PG8_STAGE(PG8_SB(1, 1), b3 + hstepB, voffB, false); PG8_STAGE(PG8_SA(1, 0), a3, voffA, f2); \
            PG8_WAIT_V(8); PG8_WAIT_L(0); PG8_BAR; PG8_MMA(F8K, 1, 0, At, B0); PG8_MMA(F8K, 1, 1, At, B1); PG8_BAR; PG8_SCHED; \
        }
    Unit cur, nxt; int ui = 0;
    if (!S.next(0, cur)) return;
    f32x4 acc[2][2][4][2];
#pragma unroll
    for (int a = 0; a < 2; ++a)
#pragma unroll
        for (int b = 0; b < 2; ++b)
#pragma unroll
            for (int m = 0; m < 4; ++m)
#pragma unroll
                for (int n = 0; n < 2; ++n) acc[a][b][m][n] = (f32x4){0.f, 0.f, 0.f, 0.f};
    bf16x8 At[4][2], B0[2][2], B1[2][2]; i32x8 At8[4], B08[2], B18[2];
    bool cF8; const char* cA; const char* cB; size_t chs; int cnt;
    MX_UNIT(cur, cF8, cA, cB, chs, cnt);
    PG8_STAGE(PG8_SB(0, 0), cB, voffB, false); PG8_STAGE(PG8_SB(0, 1), cB + hstepB, voffB, false); PG8_STAGE(PG8_SA(0, 0), cA, voffA, cF8); PG8_STAGE(PG8_SA(0, 1), cA + chs, voffA, cF8);
    if (wr == 1) PG8_BAR;
    PG8_WAIT_V(2); PG8_BAR;
    PG8_STAGE(PG8_SB(1, 0), cB + kstepB, voffB, false); PG8_STAGE(PG8_SA(1, 0), cA + kstep, voffA, cF8); PG8_STAGE(PG8_SB(1, 1), cB + hstepB + kstepB, voffB, false);
    PG8_WAIT_V(6); PG8_BAR;
    for (;;) {
        const bool has_next = S.next(ui + 1, nxt);
        bool nF8 = cF8; const char* nA = cA; const char* nB = cB; size_t nhs = chs; int nnt = cnt;
        if (has_next) MX_UNIT(nxt, nF8, nA, nB, nhs, nnt);
        if (cF8) { MX_KLOOP(true) } else { MX_KLOOP(false) }
        if (wr == 0) PG8_BAR;
        asm volatile("s_nop 15\n\ts_nop 15" ::: "memory");
        E(acc, cur, wr, wc, fr, fq);
        if (!has_next) break;
#pragma unroll
        for (int a = 0; a < 2; ++a)
#pragma unroll
            for (int b = 0; b < 2; ++b)
#pragma unroll
                for (int m = 0; m < 4; ++m)
#pragma unroll
                    for (int n = 0; n < 2; ++n) acc[a][b][m][n] = (f32x4){0.f, 0.f, 0.f, 0.f};
        cur = nxt; cA = nA; cB = nB; cF8 = nF8; chs = nhs; cnt = nnt; ++ui;
        if (wr == 1) PG8_BAR;
    }
    PG8_WAIT_V(0);
    PG8_BAR;
#undef PG8_SA
#undef PG8_SB
#undef MX_OFF
#undef MX_UNIT
#undef MX_KLOOP
#undef PG8_STAGE
#undef PG8_LDA
#undef PG8_LDB
#undef PG8_MMA
#undef PG8_CAT
#undef PG8_WAIT_V
#undef PG8_WAIT_L
#undef PG8_BAR
#undef PG8_SCHED
}
}

constexpr int M = 16384, D = 1024, NL = 4, NWAVES = 8;
constexpr int IN_COLS = 7936, PROJ_COLS = 3840, GATE_COLS = 4096, FF = 2816, NE = 8;
constexpr int PC_Q = 0, PC_K = 512, PC_V = 640, PC_CB = 768, PC_CC = 1280, PC_CX = 1792, PC_P = 2304, PC_U = 2816, PC_SV = 3328;
constexpr int MAXROWS = 34816;
constexpr float RMS_EPS = 1e-6f;
constexpr float LOG2E = 1.4426950408889634f;
constexpr float W8_SCALE = 64.0f;
constexpr float A8_SCALE = 8.0f;

constexpr size_t MiB = 1u << 20;
constexpr size_t WS_CTL = 0, CTL_ZERO_BYTES = 1 * MiB;
constexpr size_t WS_WIN = 1 * MiB;
constexpr size_t WS_WIN8 = 31 * MiB;
constexpr size_t WS_X8 = 47 * MiB;
constexpr size_t WS_WBR = 63 * MiB;
constexpr size_t WS_WOUT = 79 * MiB;
constexpr size_t WS_DGU = 87 * MiB;
constexpr size_t WS_DD = 109 * MiB;
constexpr size_t WS_MGU = 120 * MiB;
constexpr size_t WS_MD = 296 * MiB;
constexpr size_t WS_PWT = 384 * MiB;
constexpr size_t WS_SW = 384 * MiB + 512 * 1024;
constexpr size_t WS_X = 385 * MiB;
constexpr size_t WS_XB = 449 * MiB;
constexpr size_t WS_SS = 481 * MiB;
constexpr size_t WS_TOK = 482 * MiB;
constexpr size_t WS_PROJ = 483 * MiB;
constexpr size_t WS_MRG32 = 483 * MiB;
constexpr size_t WS_MRG = 547 * MiB;
constexpr size_t WS_G = 603 * MiB;
constexpr size_t WS_BR = 731 * MiB;
constexpr size_t WS_ACT = 483 * MiB;
constexpr size_t WS_XG = 577 * MiB;
constexpr size_t WS_Y = 738 * MiB;
constexpr size_t WS_END = 806 * MiB;
static_assert(WS_ACT + (size_t)M * FF * 2 <= WS_XG && WS_ACT + (size_t)MAXROWS * FF <= WS_XG && WS_XG + (size_t)8 * 16384 * D <= WS_Y && WS_Y + (size_t)MAXROWS * D * 2 <= WS_END, "ws map");
static_assert(WS_MRG32 + (size_t)M * D * 4 <= WS_MRG && WS_MRG + (size_t)M * D * 2 <= WS_G && WS_PROJ + (size_t)M * PROJ_COLS * 2 <= WS_G, "ws map 2");
constexpr int CW_TMO = 0;
constexpr int CW_BAR = 4096;
constexpr int CW_CNT = 8192;

constexpr int RING_BYTES = 131072;
constexpr int MISC_OFF = RING_BYTES + 320;
constexpr int RSL_OFF = RING_BYTES + 1024;
constexpr int LDS_BYTES = 147456;

#define GAS __attribute__((address_space(1)))
#define LAS __attribute__((address_space(3)))
typedef unsigned short bf16;
typedef unsigned v4u __attribute__((ext_vector_type(4)));
typedef unsigned v2u __attribute__((ext_vector_type(2)));
typedef float f32x4 __attribute__((ext_vector_type(4)));
typedef short bf16x8 __attribute__((ext_vector_type(8)));
typedef short s16x4 __attribute__((ext_vector_type(4)));
#define LDS_WAIT() asm volatile("s_waitcnt lgkmcnt(0)" ::: "memory")
__device__ __forceinline__ float bf2f(unsigned short b) { return __uint_as_float(((unsigned)b) << 16); }
__device__ __forceinline__ float bflo(unsigned w) { return __uint_as_float(w << 16); }
__device__ __forceinline__ float bfhi(unsigned w) { return __uint_as_float(w & 0xffff0000u); }
__device__ __forceinline__ unsigned pk2(float lo, float hi) { return pg8::cvt_pk_bf16(lo, hi); }
__device__ __forceinline__ unsigned pk4_fp8(float a, float b, float c, float d) { int w = 0; w = __builtin_amdgcn_cvt_pk_fp8_f32(a, b, w, false); w = __builtin_amdgcn_cvt_pk_fp8_f32(c, d, w, true); return (unsigned)w; }
__device__ __forceinline__ float fast_sigmoid(float v) { return __builtin_amdgcn_rcpf(1.0f + __builtin_amdgcn_exp2f(-v * LOG2E)); }
#define WS_DPP(x, ctrl, rmask) __int_as_float(__builtin_amdgcn_update_dpp(0, __float_as_int(x), ctrl, rmask, 0xF, false))
__device__ __forceinline__ float rows_sum(float v) {
    { const auto r = __builtin_amdgcn_permlane16_swap(__float_as_uint(v), __float_as_uint(v), false, false); v = __uint_as_float(r[0]) + __uint_as_float(r[1]); }
    { const auto r = __builtin_amdgcn_permlane32_swap(__float_as_uint(v), __float_as_uint(v), false, false); v = __uint_as_float(r[0]) + __uint_as_float(r[1]); }
    return v;
}
__device__ __forceinline__ float rows_max(float v) {
    { const auto r = __builtin_amdgcn_permlane16_swap(__float_as_uint(v), __float_as_uint(v), false, false); v = fmaxf(__uint_as_float(r[0]), __uint_as_float(r[1])); }
    { const auto r = __builtin_amdgcn_permlane32_swap(__float_as_uint(v), __float_as_uint(v), false, false); v = fmaxf(__uint_as_float(r[0]), __uint_as_float(r[1])); }
    return v;
}
__device__ __forceinline__ float wave_sum(float v) {
    v += WS_DPP(v, 0xB1, 0xF);
    v += WS_DPP(v, 0x4E, 0xF);
    v += WS_DPP(v, 0x141, 0xF);
    v += WS_DPP(v, 0x140, 0xF);
    v += WS_DPP(v, 0x142, 0xA);
    v += WS_DPP(v, 0x143, 0xC);
    return __int_as_float(__builtin_amdgcn_readlane(__float_as_int(v), 63));
}

#define XB_TMO      128
#define XB_XCNT(j)  (256  + 64 * (j))
#define XB_XSUB(j)  (1280 + 64 * (j))
#define XB_XGEN(j)  (2304 + 64 * (j))
#define XB_TOP      3328
#define XB_TOPGEN   3392
#define XCD_BAR_WORDS 3456
#define XB_SPIN_CAP (1u << 18)
__device__ __forceinline__ unsigned xb_ld(unsigned* p)              { return __hip_atomic_load(p, __ATOMIC_RELAXED, __HIP_MEMORY_SCOPE_AGENT); }
__device__ __forceinline__ unsigned xb_add(unsigned* p, unsigned v) { return __hip_atomic_fetch_add(p, v, __ATOMIC_RELAXED, __HIP_MEMORY_SCOPE_AGENT); }
__device__ __forceinline__ unsigned xb_xcc_id() { return (unsigned)__builtin_amdgcn_s_getreg((3 << 11) | 20) & 0xFu; }
#define XB_SPIN(cond, bar) do { unsigned _sp = 0; while (cond) { __builtin_amdgcn_s_sleep(1); \
    if ((++_sp & 255u) == 0u) { if (xb_ld(&(bar)[XB_TMO])) break; if (_sp > XB_SPIN_CAP) { atomicAdd(&(bar)[XB_TMO], 1u); break; } } } } while (0)
struct XcdBarrier { unsigned* bar; unsigned x; volatile LAS unsigned* st; };
__device__ __forceinline__ XcdBarrier xcd_barrier_post(unsigned* bar, volatile LAS unsigned* st) {
    XcdBarrier b; b.bar = bar; b.x = xb_xcc_id(); b.st = st;
    if (threadIdx.x == 0) (void)xb_add(&bar[XB_XCNT(b.x)], 1u);
    return b;
}
__device__ __forceinline__ void xcd_barrier_complete(unsigned* bar, unsigned x, unsigned& nloc, unsigned& nx) {
    const unsigned G = gridDim.x * gridDim.y * gridDim.z;
    unsigned sum, cnt, mine, sp = 0u;
    for (;;) {
        sum = 0u; cnt = 0u; mine = 0u;
#pragma unroll
        for (unsigned j = 0; j < 16; ++j) { const unsigned c = xb_ld(&bar[XB_XCNT(j)]); sum += c; cnt += (c > 0u) ? 1u : 0u; mine = (j == x) ? c : mine; }
        if (sum == G) break;
        __builtin_amdgcn_s_sleep(1);
        if ((++sp & 255u) == 0u) { if (xb_ld(&bar[XB_TMO])) break; if (sp > XB_SPIN_CAP) { atomicAdd(&bar[XB_TMO], 1u); break; } }
    }
    nloc = mine > 0u ? mine : 1u; nx = cnt > 0u ? cnt : 1u;
}
__device__ __forceinline__ void xcd_barrier(const XcdBarrier& b) {
    asm volatile("s_waitcnt vmcnt(0)" ::: "memory");
    __syncthreads();
    if (threadIdx.x == 0) {
        unsigned* bar = b.bar;
        __builtin_amdgcn_s_waitcnt(0);
        unsigned nloc = b.st[0], nx = b.st[1];
        if (nloc == 0u) { xcd_barrier_complete(bar, b.x, nloc, nx); b.st[0] = nloc; b.st[1] = nx; }
        const unsigned old = xb_add(&bar[XB_XSUB(b.x)], 1u);
        const unsigned gen = old / nloc;
        if (old + 1u == (gen + 1u) * nloc) {
            __builtin_amdgcn_fence(__ATOMIC_RELEASE, "agent");
            asm volatile("s_waitcnt vmcnt(0)" ::: "memory");
            const unsigned og = xb_add(&bar[XB_TOP], 1u);
            const unsigned tg = og / nx;
            if (og + 1u == (tg + 1u) * nx) xb_add(&bar[XB_TOPGEN], 1u);
            else XB_SPIN(xb_ld(&bar[XB_TOPGEN]) == tg, bar);
            __builtin_amdgcn_fence(__ATOMIC_ACQUIRE, "agent");
            xb_add(&bar[XB_XGEN(b.x)], 1u);
            asm volatile("s_waitcnt vmcnt(0)" ::: "memory");
        } else {
            XB_SPIN(xb_ld(&bar[XB_XGEN(b.x)]) == gen, bar);
            __builtin_amdgcn_fence(__ATOMIC_ACQUIRE, "agent");
            asm volatile("s_waitcnt vmcnt(0)" ::: "memory");
        }
    }
    __syncthreads();
}

using pg8::Unit;
__device__ __forceinline__ float row_rscale(const float* SS, int row) {
    const f32x4 a = *(const f32x4*)(SS + (size_t)row * 4), b = *(const f32x4*)(SS + ((size_t)M + row) * 4), c = *(const f32x4*)(SS + ((size_t)2 * M + row) * 4), d = *(const f32x4*)(SS + ((size_t)3 * M + row) * 4);
    const float s = ((a[0] + a[1]) + (a[2] + a[3])) + ((b[0] + b[1]) + (b[2] + b[3])) + ((c[0] + c[1]) + (c[2] + c[3])) + ((d[0] + d[1]) + (d[2] + d[3]));
    return 1.0f / sqrtf(s * (1.0f / D) + RMS_EPS);
}
__device__ __forceinline__ unsigned gate_frag_off(int pm, int gt, int wave, int am, int lane) { return (unsigned)((((pm * 16 + gt) * 8 + wave) * 8 + am) * 1024 + lane * 16); }
struct EpiG1 {
    __device__ __forceinline__ bool zero_after(const Unit&) const { return true; }
    bf16* PROJ; bf16* G; const float* SS; const LAS float* RSL; int pm0;
    __device__ __forceinline__ void operator()(const f32x4 (&acc)[2][2][4][2], const Unit& u, int wr, int wc, int fr, int fq) const {
        const int row0 = u.pm * 256 + wr * 64 + fr;
        const bool gate = u.pn >= 15;
        float rs[2][4];
        if (u.pm == pm0) {
#pragma unroll
            for (int ai = 0; ai < 2; ++ai)
#pragma unroll
                for (int m = 0; m < 4; ++m) rs[ai][m] = RSL[ai * 128 + wr * 64 + m * 16 + fr];
        } else {
#pragma unroll
            for (int ai = 0; ai < 2; ++ai)
#pragma unroll
                for (int m = 0; m < 4; ++m) rs[ai][m] = row_rscale(SS, row0 + ai * 128 + m * 16);
        }
#pragma unroll
        for (int ai = 0; ai < 2; ++ai)
#pragma unroll
            for (int m = 0; m < 4; ++m) { const int row = row0 + ai * 128 + m * 16; const float r = rs[ai][m];
                if (gate) {
                    unsigned w4[4];
                    const float kr = r * (-LOG2E / W8_SCALE);
#pragma unroll
                    for (int bj = 0; bj < 2; ++bj) { unsigned lo = 0u, hi = 0u;
#define GATE8(x) fmaxf(__builtin_rintf(__builtin_amdgcn_rcpf(__builtin_fmaf(__builtin_amdgcn_exp2f((x) * kr), 1.0f / 255.0f, 1.0f / 255.0f))), 1.0f)
                        lo = __builtin_amdgcn_cvt_pk_u8_f32(GATE8(acc[ai][bj][m][0][0]), 0, lo); lo = __builtin_amdgcn_cvt_pk_u8_f32(GATE8(acc[ai][bj][m][0][1]), 1, lo);
                        lo = __builtin_amdgcn_cvt_pk_u8_f32(GATE8(acc[ai][bj][m][0][2]), 2, lo); lo = __builtin_amdgcn_cvt_pk_u8_f32(GATE8(acc[ai][bj][m][0][3]), 3, lo);
                        hi = __builtin_amdgcn_cvt_pk_u8_f32(GATE8(acc[ai][bj][m][1][0]), 0, hi); hi = __builtin_amdgcn_cvt_pk_u8_f32(GATE8(acc[ai][bj][m][1][1]), 1, hi);
                        hi = __builtin_amdgcn_cvt_pk_u8_f32(GATE8(acc[ai][bj][m][1][2]), 2, hi); hi = __builtin_amdgcn_cvt_pk_u8_f32(GATE8(acc[ai][bj][m][1][3]), 3, hi);
#undef GATE8
                        w4[2 * bj] = lo; w4[2 * bj + 1] = hi; }
                    *(v4u*)((unsigned char*)G + gate_frag_off(u.pm, u.pn - 15, wr * 4 + wc, ai * 4 + m, fq * 16 + fr)) = (v4u){w4[0], w4[1], w4[2], w4[3]};
                } else {
                    bf16* rowp = PROJ + (size_t)row * PROJ_COLS + u.pn * 256 + wc * 32 + 8 * fq;
#pragma unroll
                    for (int bj = 0; bj < 2; ++bj) { const f32x4 v0 = acc[ai][bj][m][0] * r, v1 = acc[ai][bj][m][1] * r;
                        v4u w; w.x = pk2(v0[0], v0[1]); w.y = pk2(v0[2], v0[3]); w.z = pk2(v1[0], v1[1]); w.w = pk2(v1[2], v1[3]);
                        *(v4u*)(rowp + bj * 128) = w; } } }
    }
};
struct EpiB1 {
    const unsigned char* G8; bf16* MRG;
    __device__ __forceinline__ bool zero_after(const Unit& u) const { return (u.pn >> 2) == 3; }
    __device__ __forceinline__ void operator()(f32x4 (&acc)[2][2][4][2], const Unit& u, int wr, int wc, int fr, int fq) const {
        const int n = u.pn >> 2, pn = u.pn & 3, pm = u.pm & 63;
        const int row0 = pm * 256 + wr * 64 + fr, col0 = pn * 256 + wc * 32 + 8 * fq;
        v4u ga[2][4], gb[2][4];
        { const unsigned char* gp = G8 + gate_frag_off(pm, n * 4 + pn, wr * 4 + wc, 0, fq * 16 + fr);
#pragma unroll
          for (int ai = 0; ai < 2; ++ai)
#pragma unroll
            for (int m = 0; m < 4; ++m) { ga[ai][m] = *(const v4u*)(gp + (ai * 4 + m) * 1024); if (n < 3) gb[ai][m] = *(const v4u*)(gp + 4 * 65536 + (ai * 4 + m) * 1024); } }
#pragma unroll
        for (int ai = 0; ai < 2; ++ai) {
#pragma unroll
            for (int m = 0; m < 4; ++m)
#pragma unroll
                for (int bj = 0; bj < 2; ++bj) {
                    float f[8];
#pragma unroll
                    for (int j = 0; j < 8; ++j) { const unsigned wa = bj == 0 ? (j < 4 ? ga[ai][m].x : ga[ai][m].y) : (j < 4 ? ga[ai][m].z : ga[ai][m].w); const float num = (float)((wa >> (8 * (j & 3))) & 0xffu);
                        if (n < 3) { const unsigned wb = bj == 0 ? (j < 4 ? gb[ai][m].x : gb[ai][m].y) : (j < 4 ? gb[ai][m].z : gb[ai][m].w); f[j] = num * __builtin_amdgcn_rcpf((float)((wb >> (8 * (j & 3))) & 0xffu)); }
                        else f[j] = num * (1.0f / 255.0f); }
                    f32x4 v0 = acc[ai][bj][m][0], v1 = acc[ai][bj][m][1];
                    v0[0] *= f[0]; v0[1] *= f[1]; v0[2] *= f[2]; v0[3] *= f[3]; v1[0] *= f[4]; v1[1] *= f[5]; v1[2] *= f[6]; v1[3] *= f[7];
                    if (n < 3) { acc[ai][bj][m][0] = v0; acc[ai][bj][m][1] = v1; }
                    else { v4u w; w.x = pk2(v0[0], v0[1]); w.y = pk2(v0[2], v0[3]); w.z = pk2(v1[0], v1[1]); w.w = pk2(v1[2], v1[3]);
                        *(v4u*)(MRG + (size_t)(row0 + ai * 128 + m * 16) * D + col0 + bj * 128) = w; } }
        }
    }
};
template <bool W8, bool SC8> struct EpiRes {
    __device__ __forceinline__ bool zero_after(const Unit&) const { return true; }
    bf16* XB; float* SS; unsigned char* X8;
    static constexpr float scale = SC8 ? 1.0f / (W8_SCALE * A8_SCALE) : 1.0f;
    __device__ __forceinline__ void operator()(const f32x4 (&acc)[2][2][4][2], const Unit& u, int wr, int wc, int fr, int fq) const {
        const int row0 = u.pm * 256 + wr * 64 + fr, col0 = u.pn * 256 + wc * 32 + 8 * fq;
#pragma unroll
        for (int ai = 0; ai < 2; ++ai) {
            v4u xv[4][2];
#pragma unroll
            for (int m = 0; m < 4; ++m)
#pragma unroll
                for (int bj = 0; bj < 2; ++bj) xv[m][bj] = *(const v4u*)(XB + (size_t)(row0 + ai * 128 + m * 16) * D + col0 + bj * 128);
#pragma unroll
            for (int m = 0; m < 4; ++m) { const int row = row0 + ai * 128 + m * 16; float s = 0.f;
#pragma unroll
                for (int bj = 0; bj < 2; ++bj) { const size_t off = (size_t)row * D + col0 + bj * 128; const v4u xa = xv[m][bj];
                    const f32x4 x0 = (f32x4){bflo(xa.x), bfhi(xa.x), bflo(xa.y), bfhi(xa.y)}, x1 = (f32x4){bflo(xa.z), bfhi(xa.z), bflo(xa.w), bfhi(xa.w)};
                    const f32x4 v0 = x0 + acc[ai][bj][m][0] * scale, v1 = x1 + acc[ai][bj][m][1] * scale;
                    { v4u w; w.x = pk2(v0[0], v0[1]); w.y = pk2(v0[2], v0[3]); w.z = pk2(v1[0], v1[1]); w.w = pk2(v1[2], v1[3]); *(v4u*)(XB + off) = w; }
                    if (W8 && X8) { v2u w8; w8.x = pk4_fp8(v0[0], v0[1], v0[2], v0[3]); w8.y = pk4_fp8(v1[0], v1[1], v1[2], v1[3]); *(v2u*)(X8 + off) = w8; }
                    s += (v0[0] * v0[0] + v0[1] * v0[1]) + (v0[2] * v0[2] + v0[3] * v0[3]) + (v1[0] * v1[0] + v1[1] * v1[1]) + (v1[2] * v1[2] + v1[3] * v1[3]); }
                s = rows_sum(s);
                if (fq == 0) SS[((size_t)u.pn * M + row) * 4 + wc] = s; }
            asm volatile("" ::: "memory");
        }
    }
};
template <bool SCALED> struct EpiGU {
    __device__ __forceinline__ bool zero_after(const Unit&) const { return true; }
    bf16* ACT; const float* SS; const LAS float* RSL; int pm0;
    __device__ __forceinline__ void operator()(const f32x4 (&acc)[2][2][4][2], const Unit& u, int wr, int wc, int fr, int fq) const {
        const int row0 = u.pm * 256 + wr * 64 + fr, col0 = (u.pn % 22) * 128 + wc * 32 + 8 * fq;
#pragma unroll
        for (int ai = 0; ai < 2; ++ai)
#pragma unroll
            for (int m = 0; m < 4; ++m) { const int row = row0 + ai * 128 + m * 16; const float r = SCALED ? (u.pm == pm0 ? RSL[ai * 128 + wr * 64 + m * 16 + fr] : row_rscale(SS, row)) : 1.0f;
                float o[8];
#pragma unroll
                for (int n = 0; n < 2; ++n)
#pragma unroll
                    for (int j = 0; j < 4; ++j) { const float gt = acc[ai][0][m][n][j] * r, up = acc[ai][1][m][n][j] * r; o[n * 4 + j] = gt * fast_sigmoid(gt) * up; }
                v4u w; w.x = pk2(o[0], o[1]); w.y = pk2(o[2], o[3]); w.z = pk2(o[4], o[5]); w.w = pk2(o[6], o[7]);
                *(v4u*)(ACT + (size_t)row * FF + col0) = w; }
    }
};
struct EpiGU8 {
    __device__ __forceinline__ bool zero_after(const Unit&) const { return true; }
    unsigned char* ACT8; const LAS float* RSL; const float* SS; int pm0;
    __device__ __forceinline__ void operator()(const f32x4 (&acc)[2][2][4][2], const Unit& u, int wr, int wc, int fr, int fq) const {
        const int row0 = u.pm * 256 + wr * 64 + fr, col0 = (u.pn % 22) * 128 + wc * 32 + 8 * fq;
#pragma unroll
        for (int ai = 0; ai < 2; ++ai)
#pragma unroll
            for (int m = 0; m < 4; ++m) { const int row = row0 + ai * 128 + m * 16; const float r = RSL ? (u.pm == pm0 ? RSL[ai * 128 + wr * 64 + m * 16 + fr] : row_rscale(SS, row)) : 1.0f;
                float o[8];
#pragma unroll
                for (int n = 0; n < 2; ++n)
#pragma unroll
                    for (int j = 0; j < 4; ++j) { const float gt = acc[ai][0][m][n][j] * (r * (1.0f / W8_SCALE)), up = acc[ai][1][m][n][j] * (r * (A8_SCALE / W8_SCALE)); o[n * 4 + j] = gt * fast_sigmoid(gt) * up; }
#pragma unroll
                for (int j = 0; j < 8; ++j) o[j] = __builtin_amdgcn_fmed3f(o[j], -448.0f, 448.0f);
                v2u w; w.x = pk4_fp8(o[0], o[1], o[2], o[3]); w.y = pk4_fp8(o[4], o[5], o[6], o[7]);
                *(v2u*)(ACT8 + (size_t)row * FF + col0) = w; }
    }
};
struct EpiY {
    __device__ __forceinline__ bool zero_after(const Unit&) const { return true; }
    bf16* Y; float scale;
    __device__ __forceinline__ void operator()(const f32x4 (&acc)[2][2][4][2], const Unit& u, int wr, int wc, int fr, int fq) const {
        const int row0 = u.pm * 256 + wr * 64 + fr, col0 = (u.pn & 3) * 256 + wc * 32 + 8 * fq;
#pragma unroll
        for (int ai = 0; ai < 2; ++ai)
#pragma unroll
            for (int m = 0; m < 4; ++m) { bf16* rowp = Y + (size_t)(row0 + ai * 128 + m * 16) * D + col0;
#pragma unroll
                for (int bj = 0; bj < 2; ++bj) { const f32x4 v0 = acc[ai][bj][m][0] * scale, v1 = acc[ai][bj][m][1] * scale;
                    v4u w; w.x = pk2(v0[0], v0[1]); w.y = pk2(v0[2], v0[3]); w.z = pk2(v1[0], v1[1]); w.w = pk2(v1[2], v1[3]);
                    *(v4u*)(rowp + bj * 128) = w; } }
    }
};
struct B1Order {
    pg8::StaticOrder so;
    __device__ __forceinline__ bool next(int i, Unit& u) const { Unit q; if (!so.next(i >> 2, q)) return false; const int n = i & 3; u.pm = n * 64 + q.pm; u.pn = n * 4 + q.pn; u.pa = u.pm; return true; }
};
constexpr int XG_CAP = 16384, XG_CAP_TILES = XG_CAP / 256;
struct MoeOrder {
    pg8::StaticOrder so; int tb1, tb2, tb3, tb4, tb5, tb6, tb7; int nN; int fixedA;
    __device__ __forceinline__ bool next(int i, Unit& u) const { Unit q; if (!so.next(i, q)) return false;
        const int e = (q.pm >= tb1) + (q.pm >= tb2) + (q.pm >= tb3) + (q.pm >= tb4) + (q.pm >= tb5) + (q.pm >= tb6) + (q.pm >= tb7);
        int tbe = 0; tbe = e == 1 ? tb1 : tbe; tbe = e == 2 ? tb2 : tbe; tbe = e == 3 ? tb3 : tbe; tbe = e == 4 ? tb4 : tbe; tbe = e == 5 ? tb5 : tbe; tbe = e == 6 ? tb6 : tbe; tbe = e == 7 ? tb7 : tbe;
        u.pm = q.pm; u.pn = e * nN + q.pn; u.pa = fixedA ? e * XG_CAP_TILES + (q.pm - tbe) : q.pm; return true; }
};

struct Args { const float* in[21]; float* out; unsigned char* ws; int ph_lo, ph_hi; };
static_assert(sizeof(Args) == 21 * 8 + 8 + 8 + 8, "Args has no padding");
enum { IN_X = 0, IN_LNMIX, IN_WIN, IN_SINK, IN_CONVW, IN_POOLW, IN_POOLS, IN_SGUW, IN_SGUB, IN_WBR, IN_WOUT, IN_LNFFN, IN_DG, IN_DU, IN_DD, IN_RW, IN_RB, IN_MG, IN_MU, IN_MD, IN_LNF };
constexpr int PH_PER_LAYER = 9, N_PHASES = 1 + NL * PH_PER_LAYER;

__device__ __forceinline__ size_t btile_off(int drow, int kbyte, int Kbytes) {
    const int pn = drow >> 8, h = (drow >> 7) & 1, g = drow & 127, gl = g & 31;
    const int R = (g & ~31) + 16 * ((gl >> 2) & 1) + 4 * (gl >> 3) + (gl & 3);
    const int kt = kbyte >> 7, cb = kbyte & 127, st = (R >> 4) * 2 + (cb >> 6), ob = (R & 15) * 64 + (cb & 63);
    return ((size_t)((pn * (Kbytes >> 7) + kt) * 2 + h) << 14) + (size_t)(st * 1024 + (ob ^ (((ob >> 9) & 1) << 5)));
}
__device__ __forceinline__ void p0_item(const float* W, int K, int N, int n_lo, int ncols, bf16* WT, const float* gk, int il, int roff, int f8, LAS unsigned char* scr, int item, int lane, bool tm) {
    const int nblk = ncols >> 6, kb = item / nblk, nb = item - kb * nblk, k0 = kb * 64, n0 = nb * 64;
    const int r = lane >> 4, c4 = lane & 15;
    f32x4 v[16];
#pragma unroll
    for (int i = 0; i < 16; ++i) v[i] = *(const f32x4*)(W + (size_t)(k0 + 4 * i + r) * N + n_lo + n0 + 4 * c4);
    if (gk) {
#pragma unroll
        for (int i = 0; i < 16; ++i) v[i] = v[i] * gk[k0 + 4 * i + r]; }
    if (f8) {
#pragma unroll
        for (int i = 0; i < 16; ++i) v[i] = v[i] * W8_SCALE; }
#pragma unroll
    for (int i = 0; i < 16; ++i) { LAS unsigned* d = (LAS unsigned*)(scr + (4 * i + r) * 132 + c4 * 8); d[0] = pk2(v[i][0], v[i][1]); d[1] = pk2(v[i][2], v[i][3]); }
    LDS_WAIT(); asm volatile("" ::: "memory");
    const int c = lane & 7, nr = lane >> 3;
#pragma unroll
    for (int j = 0; j < 8; ++j) { const int n = 8 * j + nr;
        const LAS unsigned short* s = (const LAS unsigned short*)(scr + (8 * c) * 132 + n * 2);
        v4u o; o.x = (unsigned)s[0] | ((unsigned)s[66] << 16); o.y = (unsigned)s[2 * 66] | ((unsigned)s[3 * 66] << 16);
        o.z = (unsigned)s[4 * 66] | ((unsigned)s[5 * 66] << 16); o.w = (unsigned)s[6 * 66] | ((unsigned)s[7 * 66] << 16);
        const int ng = n0 + n; const int drow = il ? ((ng >> 7) * 256 + (ng & 127) + roff) : (ng + roff);
        if (f8) { v2u o8; o8.x = pk4_fp8(bflo(o.x), bfhi(o.x), bflo(o.y), bfhi(o.y)); o8.y = pk4_fp8(bflo(o.z), bfhi(o.z), bflo(o.w), bfhi(o.w));
            *(v2u*)((unsigned char*)WT + btile_off(drow, k0 + 8 * c, K)) = o8; }
        else if (tm) *(v4u*)((unsigned char*)WT + btile_off(drow, (k0 + 8 * c) * 2, K * 2)) = o;
        else *(v4u*)(WT + (size_t)drow * K + k0 + 8 * c) = o; }
    LDS_WAIT(); asm volatile("" ::: "memory");
}
__device__ __forceinline__ void att_unit(LAS unsigned char* lds, const bf16* PROJ, const float* sinks, bf16* BR0, int nb, int kvh) {
    constexpr int KP = 144, VP = 528, VT_OFF = 256 * KP;
    int tid_ = threadIdx.x; asm volatile("" : "+v"(tid_)); const int tid = tid_, lane = tid & 63, wave = __builtin_amdgcn_readfirstlane(tid >> 6);
    const int g4 = wave >> 1, qh = wave & 1, head = kvh * 4 + g4, fr = lane & 15, fg = lane >> 4;
    bf16x8 qfa[4][2];
#pragma unroll
    for (int qt = 0; qt < 4; ++qt) { const bf16* qp = PROJ + (size_t)(nb * 128 + qh * 64 + qt * 16 + fr) * PROJ_COLS + PC_Q + head * 64 + 8 * fg; qfa[qt][0] = *(const bf16x8*)qp; qfa[qt][1] = *(const bf16x8*)(qp + 32); }
    const float sink_t = sinks[head] * LOG2E;
    __syncthreads();
#pragma unroll
    for (int i = 0; i < 4; ++i) { const int q = tid + 512 * i, kj = q >> 3, c = q & 7; const int tk = nb * 128 - 128 + kj;
        v4u kv = (v4u){0u, 0u, 0u, 0u}, vv = (v4u){0u, 0u, 0u, 0u};
        if (tk >= 0) { const bf16* src = PROJ + (size_t)tk * PROJ_COLS + kvh * 64 + c * 8; kv = *(const v4u*)(src + PC_K); vv = *(const v4u*)(src + PC_V); }
        *(LAS v4u*)(lds + kj * KP + c * 16) = kv;
        LAS unsigned short* vt = (LAS unsigned short*)(lds + VT_OFF + (c * 8) * VP + kj * 2);
        vt[0 * (VP / 2)] = (unsigned short)(vv.x & 0xffffu); vt[1 * (VP / 2)] = (unsigned short)(vv.x >> 16);
        vt[2 * (VP / 2)] = (unsigned short)(vv.y & 0xffffu); vt[3 * (VP / 2)] = (unsigned short)(vv.y >> 16);
        vt[4 * (VP / 2)] = (unsigned short)(vv.z & 0xffffu); vt[5 * (VP / 2)] = (unsigned short)(vv.z >> 16);
        vt[6 * (VP / 2)] = (unsigned short)(vv.w & 0xffffu); vt[7 * (VP / 2)] = (unsigned short)(vv.w >> 16); }
    __syncthreads();
#pragma unroll
    for (int qt = 0; qt < 4; ++qt) {
        const int q0 = qh * 64 + qt * 16, qi = q0 + fr, tok = nb * 128 + qi, kb0 = (q0 >> 5);
        const bf16x8 qf0 = qfa[qt][0], qf1 = qfa[qt][1];
        f32x4 sc[5][2];
#pragma unroll
        for (int b = 0; b < 5; ++b)
#pragma unroll
            for (int h2 = 0; h2 < 2; ++h2) { const int key = 32 * (kb0 + b) + 16 * h2 + fr;
                const bf16x8 kf0 = *(const LAS bf16x8*)(lds + key * KP + 16 * fg), kf1 = *(const LAS bf16x8*)(lds + key * KP + 64 + 16 * fg);
                f32x4 s = (f32x4){0.f, 0.f, 0.f, 0.f};
                s = __builtin_amdgcn_mfma_f32_16x16x32_bf16(kf0, qf0, s, 0, 0, 0);
                s = __builtin_amdgcn_mfma_f32_16x16x32_bf16(kf1, qf1, s, 0, 0, 0);
                sc[b][h2] = s; }
        float mx = sink_t;
#pragma unroll
        for (int b = 0; b < 5; ++b)
#pragma unroll
            for (int h2 = 0; h2 < 2; ++h2)
#pragma unroll
                for (int j = 0; j < 4; ++j) { const int kj = 32 * (kb0 + b) + 16 * h2 + 4 * fg + j;
                    const bool valid = (kj > qi) && (kj <= qi + 128) && (nb > 0 || kj >= 128);
                    const float t = valid ? sc[b][h2][j] * (0.125f * LOG2E) : -1e30f; sc[b][h2][j] = t; mx = fmaxf(mx, t); }
        mx = rows_max(mx);
        float sum = 0.f;
#pragma unroll
        for (int b = 0; b < 5; ++b)
#pragma unroll
            for (int h2 = 0; h2 < 2; ++h2)
#pragma unroll
                for (int j = 0; j < 4; ++j) { const float p = __builtin_amdgcn_exp2f(sc[b][h2][j] - mx); sc[b][h2][j] = p; sum += p; }
        sum = rows_sum(sum);
        const float inv = 1.0f / (sum + __builtin_amdgcn_exp2f(sink_t - mx));
        f32x4 o[4];
#pragma unroll
        for (int dt = 0; dt < 4; ++dt) o[dt] = (f32x4){0.f, 0.f, 0.f, 0.f};
#pragma unroll
        for (int b = 0; b < 5; ++b) {
            v4u pw; pw.x = pk2(sc[b][0][0], sc[b][0][1]); pw.y = pk2(sc[b][0][2], sc[b][0][3]); pw.z = pk2(sc[b][1][0], sc[b][1][1]); pw.w = pk2(sc[b][1][2], sc[b][1][3]);
            const bf16x8 pf = __builtin_bit_cast(bf16x8, pw);
#pragma unroll
            for (int dt = 0; dt < 4; ++dt) { const LAS unsigned char* vr = lds + VT_OFF + (16 * dt + fr) * VP + (32 * (kb0 + b) + 4 * fg) * 2;
                const v2u lo = *(const LAS v2u*)vr, hi = *(const LAS v2u*)(vr + 32);
                v4u vw; vw.x = lo.x; vw.y = lo.y; vw.z = hi.x; vw.w = hi.y;
                o[dt] = __builtin_amdgcn_mfma_f32_16x16x32_bf16(__builtin_bit_cast(bf16x8, vw), pf, o[dt], 0, 0, 0); } }
        bf16* op = BR0 + (size_t)tok * 512 + head * 64 + 4 * fg;
#pragma unroll
        for (int dt = 0; dt < 4; ++dt) { v2u w; w.x = pk2(o[dt][0] * inv, o[dt][1] * inv); w.y = pk2(o[dt][2] * inv, o[dt][3] * inv); *(v2u*)(op + 16 * dt) = w; }
    }
}

__device__ __forceinline__ void unpack8(const v4u a, float (&v)[8]) { v[0] = bflo(a.x); v[1] = bfhi(a.x); v[2] = bflo(a.y); v[3] = bfhi(a.y); v[4] = bflo(a.z); v[5] = bfhi(a.z); v[6] = bflo(a.w); v[7] = bfhi(a.w); }
__device__ __forceinline__ void psc_unit(LAS unsigned char* lds, const bf16* PROJ, const float* convw, const bf16* PWT, const float* pscale, const bf16* SW, const float* sgub,
                                         bf16* BR1, bf16* BR2, bf16* BR3, int T, int hf) {
    constexpr int PP = 272;
    constexpr int PL_OFF = 0, PO_OFF = 38912, VT_OFF = 73728;
    int tid_ = threadIdx.x; asm volatile("" : "+v"(tid_)); const int tid = tid_, lane = tid & 63, wave = __builtin_amdgcn_readfirstlane(tid >> 6);
    const int fr = lane & 15, fg = lane >> 4;
    { const int c8 = tid & 31, tr = tid >> 5, ch = hf * 256 + c8 * 8, t0 = T * 128 + tr * 8;
      float w0[8], w1[8], w2[8];
#pragma unroll
      for (int i = 0; i < 8; ++i) { w0[i] = convw[ch + i]; w1[i] = convw[512 + ch + i]; w2[i] = convw[1024 + ch + i]; }
      const bf16* base = PROJ + (size_t)t0 * PROJ_COLS + ch;
      float zm2[8], zm1[8];
      { v4u a2 = (v4u){0u, 0u, 0u, 0u}, b2 = a2, a1 = a2, b1 = a2;
        if (t0 >= 2) { a2 = *(const v4u*)(base - 2 * PROJ_COLS + PC_CC); b2 = *(const v4u*)(base - 2 * PROJ_COLS + PC_CX); a1 = *(const v4u*)(base - PROJ_COLS + PC_CC); b1 = *(const v4u*)(base - PROJ_COLS + PC_CX); }
        float x[8], y[8]; unpack8(a2, x); unpack8(b2, y);
#pragma unroll
        for (int k = 0; k < 8; ++k) zm2[k] = x[k] * y[k];
        unpack8(a1, x); unpack8(b1, y);
#pragma unroll
        for (int k = 0; k < 8; ++k) zm1[k] = x[k] * y[k]; }
#pragma unroll
      for (int h = 0; h < 2; ++h) { v4u ca[4], xa[4], ga[4];
#pragma unroll
          for (int i = 0; i < 4; ++i) { const bf16* p = base + (size_t)(4 * h + i) * PROJ_COLS; ca[i] = *(const v4u*)(p + PC_CC); xa[i] = *(const v4u*)(p + PC_CX); ga[i] = *(const v4u*)(p + PC_CB); }
#pragma unroll
          for (int i = 0; i < 4; ++i) { float z[8], xx[8], gb[8], y[8]; unpack8(ca[i], z); unpack8(xa[i], xx); unpack8(ga[i], gb);
#pragma unroll
              for (int k = 0; k < 8; ++k) { z[k] *= xx[k]; y[k] = gb[k] * (w0[k] * zm2[k] + w1[k] * zm1[k] + w2[k] * z[k]); zm2[k] = zm1[k]; zm1[k] = z[k]; }
              v4u w; w.x = pk2(y[0], y[1]); w.y = pk2(y[2], y[3]); w.z = pk2(y[4], y[5]); w.w = pk2(y[6], y[7]);
              *(v4u*)(BR1 + (size_t)(t0 + 4 * h + i) * 512 + ch) = w; } } }
#pragma unroll 1
    for (int gi = 0; gi < 2; ++gi) {
        const int gp = 2 * hf + gi, win = 2 << gp;
        v4u pl[5], sv[4];
#pragma unroll
        for (int i = 0; i < 5; ++i) { const int q = tid + 512 * i, r = q >> 4, c8 = q & 15, t = T * 128 - 15 + r;
            pl[i] = (v4u){0u, 0u, 0u, 0u};
            if (r < 143 && t >= 0) pl[i] = *(const v4u*)(PROJ + (size_t)t * PROJ_COLS + PC_P + gp * 128 + c8 * 8); }
#pragma unroll
        for (int i = 0; i < 4; ++i) { const int q = tid + 512 * i, s_ = q >> 4, c8 = q & 15; sv[i] = *(const v4u*)(PROJ + (size_t)(T * 128 + s_) * PROJ_COLS + PC_SV + gp * 128 + c8 * 8); }
        bf16x8 pwf[4], wsf[4];
#pragma unroll
        for (int ks = 0; ks < 4; ++ks) { pwf[ks] = *(const bf16x8*)(PWT + (size_t)gp * 16384 + (16 * wave + fr) * 128 + 32 * ks + 8 * fg);
                                         wsf[ks] = *(const bf16x8*)(SW + (size_t)gp * 16384 + (16 * wave + fr) * 128 + 32 * ks + 8 * fg); }
        __syncthreads();
#pragma unroll
        for (int i = 0; i < 5; ++i) { const int q = tid + 512 * i, r = q >> 4, c8 = q & 15; if (r < 143) *(LAS v4u*)(lds + PL_OFF + r * PP + c8 * 16) = pl[i]; }
#pragma unroll
        for (int i = 0; i < 4; ++i) { const int q = tid + 512 * i, s_ = q >> 4, c8 = q & 15; const v4u vv = sv[i];
            LAS unsigned short* vt = (LAS unsigned short*)(lds + VT_OFF + (c8 * 8) * PP + s_ * 2);
            vt[0 * (PP / 2)] = (unsigned short)(vv.x & 0xffffu); vt[1 * (PP / 2)] = (unsigned short)(vv.x >> 16);
            vt[2 * (PP / 2)] = (unsigned short)(vv.y & 0xffffu); vt[3 * (PP / 2)] = (unsigned short)(vv.y >> 16);
            vt[4 * (PP / 2)] = (unsigned short)(vv.z & 0xffffu); vt[5 * (PP / 2)] = (unsigned short)(vv.z >> 16);
            vt[6 * (PP / 2)] = (unsigned short)(vv.w & 0xffffu); vt[7 * (PP / 2)] = (unsigned short)(vv.w >> 16); }
        __syncthreads();
        { const int c8 = tid & 15, tr = tid >> 4; const LAS unsigned char* pcol = lds + PL_OFF + c8 * 16; float s[8];
#pragma unroll
          for (int k = 0; k < 8; ++k) s[k] = 0.f;
          for (int i = 0; i < win; ++i) { float v[8]; unpack8(*(const LAS v4u*)(pcol + (tr * 4 + 15 - i) * PP), v);
#pragma unroll
              for (int k = 0; k < 8; ++k) s[k] += v[k]; }
#pragma unroll
          for (int tt = 0; tt < 4; ++tt) { const int tl = tr * 4 + tt, t = T * 128 + tl; float p0[8]; unpack8(*(const LAS v4u*)(pcol + (tl + 15) * PP), p0);
              if (tt > 0) { float old[8]; unpack8(*(const LAS v4u*)(pcol + (tl + 15 - win) * PP), old);
#pragma unroll
                  for (int k = 0; k < 8; ++k) s[k] += p0[k] - old[k]; }
              const float ic = 1.0f / (float)((t + 1) < win ? (t + 1) : win);
              v4u w; w.x = pk2(s[0] * ic - p0[0], s[1] * ic - p0[1]); w.y = pk2(s[2] * ic - p0[2], s[3] * ic - p0[3]); w.z = pk2(s[4] * ic - p0[4], s[5] * ic - p0[5]); w.w = pk2(s[6] * ic - p0[6], s[7] * ic - p0[7]);
              *(LAS v4u*)(lds + PO_OFF + tl * PP + c8 * 16) = w; } }
        { const int tl = 16 * wave + fr, t = T * 128 + tl; const float bias = sgub[gp * 128 + tl];
          v2u uw[8];
#pragma unroll
          for (int ct = 0; ct < 8; ++ct) uw[ct] = *(const v2u*)(PROJ + (size_t)t * PROJ_COLS + PC_U + gp * 128 + 16 * ct + 4 * fg);
#pragma unroll
          for (int ct = 0; ct < 8; ++ct) { f32x4 a = (f32x4){0.f, 0.f, 0.f, 0.f};
#pragma unroll
              for (int ks = 0; ks < 4; ++ks) { const bf16x8 afr = *(const LAS bf16x8*)(lds + VT_OFF + (16 * ct + fr) * PP + (32 * ks + 8 * fg) * 2);
                  a = __builtin_amdgcn_mfma_f32_16x16x32_bf16(afr, wsf[ks], a, 0, 0, 0); }
              v2u w; w.x = pk2(bflo(uw[ct].x) * (a[0] + bias), bfhi(uw[ct].x) * (a[1] + bias)); w.y = pk2(bflo(uw[ct].y) * (a[2] + bias), bfhi(uw[ct].y) * (a[3] + bias));
              *(v2u*)(BR3 + (size_t)t * 512 + gp * 128 + 16 * ct + 4 * fg) = w; } }
        __syncthreads();
        { const f32x4 ps = *(const f32x4*)(pscale + gp * 128 + 16 * wave + 4 * fg);
#pragma unroll
          for (int tt = 0; tt < 8; ++tt) { f32x4 a = (f32x4){0.f, 0.f, 0.f, 0.f};
#pragma unroll
              for (int ks = 0; ks < 4; ++ks) { const bf16x8 bfr = *(const LAS bf16x8*)(lds + PO_OFF + (16 * tt + fr) * PP + (32 * ks + 8 * fg) * 2);
                  a = __builtin_amdgcn_mfma_f32_16x16x32_bf16(pwf[ks], bfr, a, 0, 0, 0); }
              v2u w; w.x = pk2(a[0] * ps[0], a[1] * ps[1]); w.y = pk2(a[2] * ps[2], a[3] * ps[3]);
              *(v2u*)(BR2 + (size_t)(T * 128 + 16 * tt + fr) * 512 + gp * 128 + 16 * wave + 4 * fg) = w; } }
    }
}

typedef const unsigned char __attribute__((address_space(4)))* kaptr_t;
__device__ __forceinline__ kaptr_t ka_get() { kaptr_t p = (kaptr_t)__builtin_amdgcn_kernarg_segment_ptr(); asm volatile("" : "+s"(p)); return p; }
#define KIN(ka, k) (*(const float* const __attribute__((address_space(4)))*)((ka) + 8 * (k)))
#define KOUT(ka) (*(float* const __attribute__((address_space(4)))*)((ka) + 168))
#define KWS(ka) (*(unsigned char* const __attribute__((address_space(4)))*)((ka) + 176))

__global__ void __launch_bounds__(NWAVES * 64, 2) trunk_fwd(Args args) {
    extern __shared__ __attribute__((aligned(16))) unsigned char lds_raw[];
    LAS unsigned char* lds = (LAS unsigned char*)lds_raw;
    volatile LAS unsigned* MISC = (volatile LAS unsigned*)(lds + MISC_OFF);
    const int G = gridDim.x, bx = blockIdx.x;
    for (int u = threadIdx.x; u < (LDS_BYTES - RING_BYTES) / 4; u += NWAVES * 64) ((LAS unsigned*)(lds + RING_BYTES))[u] = 0u;
    __syncthreads();
    XcdBarrier bar; bar.bar = (unsigned*)(args.ws + WS_CTL) + CW_BAR; bar.x = 0; bar.st = MISC + 8;
    if (!MK_PER_PHASE) bar = xcd_barrier_post((unsigned*)(args.ws + WS_CTL) + CW_BAR, MISC + 8);
    const int lo = args.ph_lo, hi = args.ph_hi;
#define IN(k) (lo <= (k) && (k) < hi)
#define SEAM_IF(c) do { if (c) { if (MK_PER_PHASE) { if (threadIdx.x == 0) __hip_atomic_store((unsigned*)(KWS(ka_get()) + WS_CTL) + CW_TMO, 0xBADBA0u, __ATOMIC_RELAXED, __HIP_MEMORY_SCOPE_AGENT); } \
        else { XcdBarrier b_; b_.bar = (unsigned*)(KWS(ka_get()) + WS_CTL) + CW_BAR; b_.x = xb_xcc_id(); b_.st = MISC + 8; xcd_barrier(b_); } } } while (0)
#define SEAM(k) SEAM_IF((k) + 1 < hi)

    if (IN(0)) {
        kaptr_t ka = ka_get(); unsigned char* ws = KWS(ka);
        const int tid = threadIdx.x, lane = tid & 63, wave = __builtin_amdgcn_readfirstlane(tid >> 6), gw = bx * NWAVES + wave, NGW = G * NWAVES;
        bf16* const WIN_T = (bf16*)(ws + WS_WIN); bf16* const WBR_T = (bf16*)(ws + WS_WBR); bf16* const WOUT_T = (bf16*)(ws + WS_WOUT);
        bf16* const DGU_T = (bf16*)(ws + WS_DGU); bf16* const DD_T = (bf16*)(ws + WS_DD); bf16* const MGU_T = (bf16*)(ws + WS_MGU); bf16* const MD_T = (bf16*)(ws + WS_MD);
        bf16* const PWT = (bf16*)(ws + WS_PWT); bf16* const SW = (bf16*)(ws + WS_SW); bf16* const XB = (bf16*)(ws + WS_XB); float* const SS = (float*)(ws + WS_SS);
        { LAS unsigned char* scr = lds + wave * 8448;
          constexpr int I_WINP = 16 * 60, I_WING = 8 * 64, I_WIN = I_WINP + I_WING, I_WBR = 8 * 16, I_WOUT = 16 * 16, I_FF = 16 * 44, I_FF8 = 8 * 44, I_PW = 4;
          constexpr int S1 = NL * I_WIN, S2 = S1 + NL * 4 * I_WBR, S3 = S2 + NL * I_WOUT, S4 = S3 + 2 * 3 * I_FF, S5 = S4 + (MOE0_F8 ? 0 : NE) * 3 * I_FF, S6 = S5 + (MOE0_F8 ? 2 * NE : NE) * 3 * I_FF8, S7 = S6 + NL * 4 * I_PW;
#pragma unroll 1
          for (int it = gw; it < S7; it += NGW) {
            const float* W; const float* gk = nullptr; bf16* WT; int K, N, il = 0, roff = 0, f8 = 0, item;
            int n_lo = 0, ncols = 0;
            if (it < S1) { const int l = it / I_WIN, r = it - l * I_WIN; W = KIN(ka, IN_WIN) + (size_t)l * D * IN_COLS; K = D; N = IN_COLS; gk = KIN(ka, IN_LNMIX) + l * D;
                if (r < I_WINP) { item = r; ncols = PROJ_COLS; WT = WIN_T + (size_t)l * PROJ_COLS * D; }
                else { item = r - I_WINP; n_lo = PROJ_COLS; ncols = GATE_COLS; f8 = 1; WT = (bf16*)(ws + WS_WIN8 + (size_t)l * GATE_COLS * D); } }
            else if (it < S2) { const int r = it - S1, q = r / I_WBR; item = r - q * I_WBR; W = KIN(ka, IN_WBR) + (size_t)q * 512 * D; K = 512; N = D; WT = WBR_T + (size_t)q * D * 512; }
            else if (it < S3) { const int r = it - S2, l = r / I_WOUT; item = r - l * I_WOUT; W = KIN(ka, IN_WOUT) + (size_t)l * D * D; K = D; N = D; WT = WOUT_T + (size_t)l * D * D; }
            else if (it < S5) { const bool moe = it >= S4; const int r = it - (moe ? S4 : S3), q = r / (3 * I_FF), r2 = r - q * 3 * I_FF, w = r2 / I_FF; item = r2 - w * I_FF;
                const int lay = moe ? 1 : 2 * q;
                if (!moe && ((DENSE_F8_MASK >> q) & 1)) f8 = 2;
                if (w < 2) { W = KIN(ka, moe ? (w ? IN_MU : IN_MG) : (w ? IN_DU : IN_DG)) + (size_t)q * D * FF; K = D; N = FF; WT = (moe ? MGU_T : DGU_T) + (size_t)q * 2 * FF * D; gk = KIN(ka, IN_LNFFN) + lay * D; il = 1; roff = w * 128; }
                else { W = KIN(ka, moe ? IN_MD : IN_DD) + (size_t)q * FF * D; K = FF; N = D; WT = (moe ? MD_T : DD_T) + (size_t)q * D * FF; } }
            else if (it < S6) { const int r = it - S5, q0 = r / (3 * I_FF8), r2 = r - q0 * 3 * I_FF8, w = r2 / I_FF8; item = r2 - w * I_FF8; f8 = 1;
                const int q = MOE0_F8 ? q0 : NE + q0, inst = q >> 3, e = q & 7;
                if (w < 2) { W = KIN(ka, w ? IN_MU : IN_MG) + (size_t)q * D * FF; K = D; N = FF; WT = (bf16*)((unsigned char*)(MGU_T + (size_t)inst * NE * 2 * FF * D) + (size_t)e * 2 * FF * D); gk = KIN(ka, IN_LNFFN) + (2 * inst + 1) * D; il = 1; roff = w * 128; }
                else { W = KIN(ka, IN_MD) + (size_t)q * FF * D; K = FF; N = D; WT = (bf16*)((unsigned char*)(MD_T + (size_t)inst * NE * D * FF) + (size_t)e * D * FF); } }
            else { const int r = it - S6, q = r / I_PW; item = r - q * I_PW; W = KIN(ka, IN_POOLW) + (size_t)q * 16384; K = 128; N = 128; WT = PWT + (size_t)q * 16384; }
            if (ncols == 0) ncols = N;
            if (f8 == 2) { const int nblk = ncols >> 6, kb = item / nblk; if (kb & 1) continue;
                p0_item(W, K, N, n_lo, ncols, WT, gk, il, roff, 1, scr, item, lane, true); item += nblk; f8 = 1; }
            else if (f8) { const int nblk = ncols >> 6, kb2 = item / nblk, nb = item - kb2 * nblk;
                p0_item(W, K, N, n_lo, ncols, WT, gk, il, roff, 1, scr, (2 * kb2) * nblk + nb, lane, true); item = (2 * kb2 + 1) * nblk + nb; }
            p0_item(W, K, N, n_lo, ncols, WT, gk, il, roff, f8, scr, item, lane, it < S6);
          } }
        { const float* sw = KIN(ka, IN_SGUW);
          for (int i = (bx * NWAVES * 64 + tid); i < NL * 4 * 16384 / 4; i += G * NWAVES * 64) { const f32x4 v = *(const f32x4*)(sw + (size_t)i * 4);
            const int e = i * 4, t = (e >> 7) & 127, s = e & 127;
            v2u w; w.x = pk2(s <= t ? v[0] : 0.f, s + 1 <= t ? v[1] : 0.f); w.y = pk2(s + 2 <= t ? v[2] : 0.f, s + 3 <= t ? v[3] : 0.f);
            *(v2u*)(SW + (size_t)e) = w; } }
        { const float* x0 = KIN(ka, IN_X);
#pragma unroll 1
          for (int m0 = gw; m0 < M; m0 += 4 * NGW) {
            f32x4 v[4][4];
#pragma unroll
            for (int q = 0; q < 4; ++q) { const int m = (m0 + q * NGW) < M ? (m0 + q * NGW) : m0; const f32x4* xr = (const f32x4*)(x0 + (size_t)m * D) + lane;
#pragma unroll
                for (int j = 0; j < 4; ++j) v[q][j] = xr[64 * j]; }
#pragma unroll
            for (int q = 0; q < 4; ++q) { const int m = m0 + q * NGW; if (m < M) { float s = 0.f;
#pragma unroll
                for (int j = 0; j < 4; ++j) { const f32x4 w4 = v[q][j]; s += (w4[0] * w4[0] + w4[1] * w4[1]) + (w4[2] * w4[2] + w4[3] * w4[3]);
                    v2u w; w.x = pk2(w4[0], w4[1]); w.y = pk2(w4[2], w4[3]); *((v2u*)(XB + (size_t)m * D) + lane + 64 * j) = w;
                    *((unsigned*)(ws + WS_X8 + (size_t)m * D) + lane + 64 * j) = pk4_fp8(w4[0], w4[1], w4[2], w4[3]); }
                s = wave_sum(s);
                if (lane < 16) SS[((size_t)(lane >> 2) * M + m) * 4 + (lane & 3)] = lane == 0 ? s : 0.f; } } } }
        SEAM(0);
    }

#pragma unroll 1
    for (int l = 0; l < NL; ++l) {
        const int pb = 1 + l * PH_PER_LAYER;
        if (IN(pb + 0)) {
            kaptr_t ka = ka_get(); unsigned char* ws = KWS(ka);
            pg8::StaticOrder S; S.init(M / 256, IN_COLS / 256, G, bx);
            Unit u0; u0.pm = -1; u0.pn = 0; const bool have0 = S.next(0, u0);
            LAS float* RSL = (LAS float*)(lds + RSL_OFF);
            { int t_ = threadIdx.x; asm volatile("" : "+v"(t_)); if (have0 && t_ < 256) RSL[t_] = row_rscale((const float*)(ws + WS_SS), u0.pm * 256 + t_); }
            __syncthreads();
            EpiG1 E{(bf16*)(ws + WS_PROJ), (bf16*)(ws + WS_G), (const float*)(ws + WS_SS), RSL, u0.pm};
            pg8::gemm_phase_mixed(lds, (const bf16*)(ws + WS_XB), (const bf16*)(ws + WS_WIN) + (size_t)l * PROJ_COLS * D, ws + WS_X8, ws + WS_WIN8 + (size_t)l * GATE_COLS * D, PROJ_COLS / 256, S, E);
            SEAM(pb + 0);
        }
        if (IN(pb + 1)) {
            kaptr_t ka = ka_get(); unsigned char* ws = KWS(ka);
            const bf16* PROJ = (const bf16*)(ws + WS_PROJ); bf16* BR = (bf16*)(ws + WS_BR);
            { const float* sinks = KIN(ka, IN_SINK) + l * 8;
              for (int u = bx; u < 256; u += G) att_unit(lds, PROJ, sinks, BR, u >> 1, u & 1); }
            { const float* convw = KIN(ka, IN_CONVW) + l * 1536; const float* pscale = KIN(ka, IN_POOLS) + l * 512; const float* sgub = KIN(ka, IN_SGUB) + l * 512;
              const bf16* PWT = (const bf16*)(ws + WS_PWT) + (size_t)l * 4 * 16384; const bf16* SW = (const bf16*)(ws + WS_SW) + (size_t)l * 4 * 16384;
              for (int u = bx; u < 256; u += G) psc_unit(lds, PROJ, convw, PWT, pscale, SW, sgub, BR + (size_t)M * 512, BR + (size_t)2 * M * 512, BR + (size_t)3 * M * 512, u >> 1, u & 1); }
            __syncthreads();
            SEAM(pb + 1);
        }
        if (IN(pb + 2)) {
            kaptr_t ka = ka_get(); unsigned char* ws = KWS(ka);
            pg8::Gemm g{(const bf16*)(ws + WS_BR), (const bf16*)(ws + WS_WBR) + (size_t)l * 4 * D * 512, 512}; B1Order S; S.so.init(64, 4, G, bx);
            EpiB1 E{(const unsigned char*)(ws + WS_G), (bf16*)(ws + WS_MRG)};
            pg8::gemm_phase<false>(lds, g, S, E);
            SEAM(pb + 2);
        }
        if (IN(pb + 3)) {
            kaptr_t ka = ka_get(); unsigned char* ws = KWS(ka);
            pg8::Gemm g{(const bf16*)(ws + WS_MRG), (const bf16*)(ws + WS_WOUT) + (size_t)l * D * D, D}; pg8::StaticOrder S; S.init(M / 256, D / 256, G, bx);
            EpiRes<DENSE_F8_MASK != 0, false> E{(bf16*)(ws + WS_XB), (float*)(ws + WS_SS), (((l & 1) == 0) && ((DENSE_F8_MASK >> (l >> 1)) & 1)) ? ws + WS_X8 : nullptr};
            pg8::gemm_phase<false>(lds, g, S, E);
            SEAM(pb + 3);
        }
        if ((l & 1) == 0) {
            const int i = l >> 1;
            if (IN(pb + 4)) {
                kaptr_t ka = ka_get(); unsigned char* ws = KWS(ka);
                pg8::StaticOrder S; S.init(M / 256, 22, G, bx);
                Unit u0; u0.pm = -1; u0.pn = 0; const bool have0 = S.next(0, u0);
                LAS float* RSL = (LAS float*)(lds + RSL_OFF);
                { int t_ = threadIdx.x; asm volatile("" : "+v"(t_)); if (have0 && t_ < 256) RSL[t_] = row_rscale((const float*)(ws + WS_SS), u0.pm * 256 + t_); }
                __syncthreads();
                if ((DENSE_F8_MASK >> i) & 1) { pg8::Gemm g{(const bf16*)(ws + WS_X8), (const bf16*)(ws + WS_DGU) + (size_t)i * 2 * FF * D, D / 2}; EpiGU8 E{ws + WS_ACT, RSL, (const float*)(ws + WS_SS), u0.pm}; pg8::gemm_phase<true>(lds, g, S, E); }
                else { pg8::Gemm g{(const bf16*)(ws + WS_XB), (const bf16*)(ws + WS_DGU) + (size_t)i * 2 * FF * D, D}; EpiGU<true> E{(bf16*)(ws + WS_ACT), (const float*)(ws + WS_SS), RSL, u0.pm}; pg8::gemm_phase<false>(lds, g, S, E); }
                SEAM(pb + 4);
            }
            if (IN(pb + 5)) {
                kaptr_t ka = ka_get(); unsigned char* ws = KWS(ka);
                pg8::StaticOrder S; S.init(M / 256, D / 256, G, bx);
                if ((DENSE_F8_MASK >> i) & 1) { pg8::Gemm g{(const bf16*)(ws + WS_ACT), (const bf16*)(ws + WS_DD) + (size_t)i * D * FF, FF / 2}; EpiRes<true, true> E{(bf16*)(ws + WS_XB), (float*)(ws + WS_SS), ws + WS_X8}; pg8::gemm_phase<true>(lds, g, S, E); }
                else { pg8::Gemm g{(const bf16*)(ws + WS_ACT), (const bf16*)(ws + WS_DD) + (size_t)i * D * FF, FF}; EpiRes<true, false> E{(bf16*)(ws + WS_XB), (float*)(ws + WS_SS), ws + WS_X8}; pg8::gemm_phase<false>(lds, g, S, E); }
                SEAM_IF(pb + 9 < hi);
            }
        } else {
            const int i = l >> 1;
            if (IN(pb + 4)) {
                kaptr_t ka = ka_get(); unsigned char* ws = KWS(ka);
                int tid_ = threadIdx.x; asm volatile("" : "+v"(tid_)); const int tid = tid_, lane = tid & 63, wave = __builtin_amdgcn_readfirstlane(tid >> 6);
                unsigned* CNT = (unsigned*)(ws + WS_CTL) + CW_CNT + i * 64;
                const bf16* XBr = (const bf16*)(ws + WS_XB);
                int* const TOKE = (int*)(ws + WS_TOK); int* const TOKP = TOKE + 2 * M; float* const TOKW = (float*)(TOKP + 2 * M);
                LAS float* WR = (LAS float*)lds;
                LAS int* LE = (LAS int*)(lds + 32768);
                LAS int* LP = (LAS int*)(lds + 33792);
                LAS unsigned char* ROWS = lds + 40960;
                unsigned char* XGF = ws + WS_XG;
                const float* rw = KIN(ka, IN_RW) + (size_t)i * D * NE; const float* gk = KIN(ka, IN_LNFFN) + l * D; const float* rb = KIN(ka, IN_RB) + i * NE;
                __syncthreads();
                { const f32x4* rw4 = (const f32x4*)(rw + (size_t)tid * 16); const f32x4 a0 = rw4[0], a1 = rw4[1], a2 = rw4[2], a3 = rw4[3];
                  const float g0 = gk[2 * tid], g1 = gk[2 * tid + 1];
#pragma unroll
                  for (int e = 0; e < 4; ++e) { WR[e * D + 2 * tid] = a0[e] * g0; WR[(e + 4) * D + 2 * tid] = a1[e] * g0; WR[e * D + 2 * tid + 1] = a2[e] * g1; WR[(e + 4) * D + 2 * tid + 1] = a3[e] * g1; } }
                __syncthreads();
                for (int ch = bx; ch < M / 64; ch += G) {
                    v2u va[8][4];
#pragma unroll
                    for (int ti = 0; ti < 8; ++ti) { const v2u* xr0 = (const v2u*)(XBr + (size_t)(ch * 64 + wave * 8 + ti) * D) + lane;
#pragma unroll
                      for (int j = 0; j < 4; ++j) va[ti][j] = xr0[64 * j]; }
#pragma unroll
                    for (int hb = 0; hb < 2; ++hb) {
                        f32x4 v[4][4]; float s[4], d[4][8];
#pragma unroll
                        for (int q = 0; q < 4; ++q) { s[q] = 0.f;
#pragma unroll
                            for (int j = 0; j < 4; ++j) { const v2u a = va[hb * 4 + q][j]; v[q][j] = (f32x4){bflo(a.x), bfhi(a.x), bflo(a.y), bfhi(a.y)};
                                s[q] += (v[q][j][0] * v[q][j][0] + v[q][j][1] * v[q][j][1]) + (v[q][j][2] * v[q][j][2] + v[q][j][3] * v[q][j][3]); }
#pragma unroll
                            for (int e = 0; e < 8; ++e) d[q][e] = 0.f; }
#pragma unroll
                        for (int e = 0; e < 8; ++e)
#pragma unroll
                            for (int j = 0; j < 4; ++j) { const f32x4 w = *((const LAS f32x4*)(WR + e * D) + lane + 64 * j);
#pragma unroll
                                for (int q = 0; q < 4; ++q) d[q][e] += (v[q][j][0] * w[0] + v[q][j][1] * w[1]) + (v[q][j][2] * w[2] + v[q][j][3] * w[3]); }
#pragma unroll
                        for (int q = 0; q < 4; ++q) { const int tl = wave * 8 + hb * 4 + q, t = ch * 64 + tl;
                            const float r = 1.0f / sqrtf(wave_sum(s[q]) * (1.0f / D) + RMS_EPS);
#pragma unroll
                            for (int j = 0; j < 4; ++j) *((LAS unsigned*)(ROWS + tl * 1024) + lane + 64 * j) = pk4_fp8(v[q][j][0] * r, v[q][j][1] * r, v[q][j][2] * r, v[q][j][3] * r);
                            float lg[8];
#pragma unroll
                            for (int e = 0; e < 8; ++e) lg[e] = wave_sum(d[q][e]) * r + rb[e];
                            int i0 = 0; float v0 = lg[0];
#pragma unroll
                            for (int e = 1; e < 8; ++e) if (lg[e] > v0) { v0 = lg[e]; i0 = e; }
                            int i1 = -1; float v1 = -3.0e38f;
#pragma unroll
                            for (int e = 0; e < 8; ++e) if (e != i0 && lg[e] > v1) { v1 = lg[e]; i1 = e; }
                            const float w1 = 1.0f / (1.0f + __expf(v0 - v1)), w0 = 1.0f - w1;
                            if (lane == 0) { LE[tl * 2] = i0; LE[tl * 2 + 1] = i1; TOKE[t * 2] = i0; TOKE[t * 2 + 1] = i1; TOKW[t * 2] = w0; TOKW[t * 2 + 1] = w1; } } }
                    __syncthreads();
                    if (tid < NE) { const int e = tid; int cnt = 0;
                        for (int q = 0; q < 128; ++q) cnt += (LE[q] == e);
                        int pos = (int)__hip_atomic_fetch_add(CNT + e, (unsigned)cnt, __ATOMIC_RELAXED, __HIP_MEMORY_SCOPE_AGENT);
                        for (int q = 0; q < 128; ++q) if (LE[q] == e) { const int t = ch * 64 + (q >> 1); TOKP[t * 2 + (q & 1)] = pos; LP[q] = pos; ++pos; } }
                    __syncthreads();
#pragma unroll
                    for (int ti = 0; ti < 8; ++ti) { const int tl = wave * 8 + ti; const v4u rowv = *(const LAS v4u*)(ROWS + tl * 1024 + lane * 16);
#pragma unroll
                        for (int k = 0; k < 2; ++k) { const int e = LE[tl * 2 + k], pos = LP[tl * 2 + k]; *(v4u*)(XGF + ((size_t)e * XG_CAP + pos) * D + lane * 16) = rowv; } }
                    __syncthreads();
                }
                SEAM(pb + 4);
            }
            if (IN(pb + 6)) {
                kaptr_t ka = ka_get(); unsigned char* ws = KWS(ka);
                unsigned* CNT = (unsigned*)(ws + WS_CTL) + CW_CNT + i * 64;
                int tb[9]; tb[0] = 0;
#pragma unroll
                for (int e = 0; e < 8; ++e) { const int c = (int)__hip_atomic_load(CNT + e, __ATOMIC_RELAXED, __HIP_MEMORY_SCOPE_AGENT); tb[e + 1] = tb[e] + ((c + 255) >> 8); }
                MoeOrder S; S.so.init(tb[8], 22, G, bx);
                S.tb1 = tb[1]; S.tb2 = tb[2]; S.tb3 = tb[3]; S.tb4 = tb[4]; S.tb5 = tb[5]; S.tb6 = tb[6]; S.tb7 = tb[7]; S.nN = 22; S.fixedA = 1;
                if (i == 0 && !MOE0_F8) { pg8::Gemm g{(const bf16*)(ws + WS_XG), (const bf16*)(ws + WS_MGU), D}; EpiGU<false> E{(bf16*)(ws + WS_ACT), nullptr, nullptr, -1}; pg8::gemm_phase<false>(lds, g, S, E); }
                else { pg8::Gemm g{(const bf16*)(ws + WS_XG), (const bf16*)(ws + WS_MGU) + (size_t)i * NE * 2 * FF * D, D / 2}; EpiGU8 E{ws + WS_ACT, nullptr, nullptr, -1}; pg8::gemm_phase<true>(lds, g, S, E); }
                SEAM(pb + 6);
            }
            if (IN(pb + 7)) {
                kaptr_t ka = ka_get(); unsigned char* ws = KWS(ka);
                unsigned* CNT = (unsigned*)(ws + WS_CTL) + CW_CNT + i * 64;
                int tb[9]; tb[0] = 0;
#pragma unroll
                for (int e = 0; e < 8; ++e) { const int c = (int)__hip_atomic_load(CNT + e, __ATOMIC_RELAXED, __HIP_MEMORY_SCOPE_AGENT); tb[e + 1] = tb[e] + ((c + 255) >> 8); }
                MoeOrder S; S.so.init(tb[8], 4, G, bx);
                S.tb1 = tb[1]; S.tb2 = tb[2]; S.tb3 = tb[3]; S.tb4 = tb[4]; S.tb5 = tb[5]; S.tb6 = tb[6]; S.tb7 = tb[7]; S.nN = 4; S.fixedA = 0;
                if (i == 0 && !MOE0_F8) { pg8::Gemm g{(const bf16*)(ws + WS_ACT), (const bf16*)(ws + WS_MD), FF}; EpiY E{(bf16*)(ws + WS_Y), 1.0f}; pg8::gemm_phase<false>(lds, g, S, E); }
                else { pg8::Gemm g{(const bf16*)(ws + WS_ACT), (const bf16*)(ws + WS_MD) + (size_t)i * NE * D * FF, FF / 2}; EpiY E{(bf16*)(ws + WS_Y), 1.0f / (W8_SCALE * A8_SCALE)}; pg8::gemm_phase<true>(lds, g, S, E); }
                SEAM(pb + 7);
            }
            if (IN(pb + 8)) {
                kaptr_t ka = ka_get(); unsigned char* ws = KWS(ka);
                int tid_ = threadIdx.x; asm volatile("" : "+v"(tid_)); const int tid = tid_, lane = tid & 63, wave = __builtin_amdgcn_readfirstlane(tid >> 6), gw = bx * NWAVES + wave, NGW = G * NWAVES;
                unsigned* CNT = (unsigned*)(ws + WS_CTL) + CW_CNT + i * 64;
                int tb[9]; tb[0] = 0;
#pragma unroll
                for (int e = 0; e < 8; ++e) { const int c = (int)__hip_atomic_load(CNT + e, __ATOMIC_RELAXED, __HIP_MEMORY_SCOPE_AGENT); tb[e + 1] = tb[e] + ((c + 255) >> 8); }
                bf16* XB = (bf16*)(ws + WS_XB); float* SS = (float*)(ws + WS_SS); const bf16* Y = (const bf16*)(ws + WS_Y);
                const int* TOKE = (const int*)(ws + WS_TOK); const int* TOKP = TOKE + 2 * M; const float* TOKW = (const float*)(TOKP + 2 * M);
                const bool last = (l == NL - 1);
                const float* gfin = KIN(ka, IN_LNF); float* outp = KOUT(ka);
#pragma unroll 1
                for (int t0 = gw; t0 < M; t0 += 4 * NGW) {
                    int ek[4][2], pk[4][2]; float wk[4][2];
#pragma unroll
                    for (int q = 0; q < 4; ++q) { const int t = (t0 + q * NGW) < M ? (t0 + q * NGW) : t0;
#pragma unroll
                        for (int k = 0; k < 2; ++k) { ek[q][k] = TOKE[t * 2 + k]; pk[q][k] = TOKP[t * 2 + k]; wk[q][k] = TOKW[t * 2 + k]; } }
                    v2u xv[4][4], ya[4][4], yb[4][4];
#pragma unroll
                    for (int q = 0; q < 4; ++q) { const int t = (t0 + q * NGW) < M ? (t0 + q * NGW) : t0;
                        const int e0 = __builtin_amdgcn_readfirstlane(ek[q][0]), e1 = __builtin_amdgcn_readfirstlane(ek[q][1]), p0 = __builtin_amdgcn_readfirstlane(pk[q][0]), p1 = __builtin_amdgcn_readfirstlane(pk[q][1]);
                        int b0 = 0, b1 = 0;
#pragma unroll
                        for (int qq = 1; qq < 8; ++qq) { b0 = (e0 == qq) ? tb[qq] : b0; b1 = (e1 == qq) ? tb[qq] : b1; }
                        const v2u* y0 = (const v2u*)(Y + (size_t)(b0 * 256 + p0) * D) + lane; const v2u* y1 = (const v2u*)(Y + (size_t)(b1 * 256 + p1) * D) + lane;
                        const v2u* xr = (const v2u*)(XB + (size_t)t * D) + lane;
#pragma unroll
                        for (int j = 0; j < 4; ++j) { xv[q][j] = xr[64 * j]; ya[q][j] = y0[64 * j]; yb[q][j] = y1[64 * j]; } }
#pragma unroll
                    for (int q = 0; q < 4; ++q) { const int t = t0 + q * NGW; if (t < M) { const float w0 = wk[q][0], w1 = wk[q][1];
                        f32x4 v[4]; float s = 0.f;
#pragma unroll
                        for (int j = 0; j < 4; ++j) { const v2u a = ya[q][j], b = yb[q][j]; f32x4 x = (f32x4){bflo(xv[q][j].x), bfhi(xv[q][j].x), bflo(xv[q][j].y), bfhi(xv[q][j].y)};
                            x[0] += w0 * bflo(a.x) + w1 * bflo(b.x); x[1] += w0 * bfhi(a.x) + w1 * bfhi(b.x); x[2] += w0 * bflo(a.y) + w1 * bflo(b.y); x[3] += w0 * bfhi(a.y) + w1 * bfhi(b.y);
                            v[j] = x; s += (x[0] * x[0] + x[1] * x[1]) + (x[2] * x[2] + x[3] * x[3]); }
                        s = wave_sum(s);
                        if (!last) {
#pragma unroll
                            for (int j = 0; j < 4; ++j) { v2u w; w.x = pk2(v[j][0], v[j][1]); w.y = pk2(v[j][2], v[j][3]); *((v2u*)(XB + (size_t)t * D) + lane + 64 * j) = w;
                                *((unsigned*)(ws + WS_X8 + (size_t)t * D) + lane + 64 * j) = pk4_fp8(v[j][0], v[j][1], v[j][2], v[j][3]); }
                            if (lane < 16) SS[((size_t)(lane >> 2) * M + t) * 4 + (lane & 3)] = lane == 0 ? s : 0.f;
                        } else {
                            const float r = 1.0f / sqrtf(s * (1.0f / D) + RMS_EPS);
                            const f32x4* gf = (const f32x4*)gfin + lane; f32x4* orow = (f32x4*)(outp + (size_t)t * D) + lane;
#pragma unroll
                            for (int j = 0; j < 4; ++j) orow[64 * j] = v[j] * r * gf[64 * j];
                        } } }
                }
                SEAM(pb + 8);
            }
        }
    }
#undef IN
#undef SEAM
#undef SEAM_IF
}

extern "C" void kernel_launch(void* const* d_in, const int* in_sizes, int n_in, void* d_out, int out_size, void* d_ws, size_t ws_size, hipStream_t stream) {
    static int grid = 0;
    if (grid == 0) {
        if (n_in != 21 || in_sizes[0] != M * D || out_size != M * D || ws_size < WS_END) { fprintf(stderr, "kernel_launch: unexpected shapes / workspace (%zu < %zu)\n", ws_size, (size_t)WS_END); grid = -1; return; }
        int dev = 0, cus = 0, per_cu = 0;
        if (hipGetDevice(&dev) != hipSuccess || hipDeviceGetAttribute(&cus, hipDeviceAttributeMultiprocessorCount, dev) != hipSuccess) { grid = -1; return; }
        if (hipFuncSetAttribute((const void*)trunk_fwd, hipFuncAttributeMaxDynamicSharedMemorySize, LDS_BYTES) != hipSuccess) { fprintf(stderr, "kernel_launch: hipFuncSetAttribute failed\n"); grid = -1; return; }
        if (hipOccupancyMaxActiveBlocksPerMultiprocessor(&per_cu, (const void*)trunk_fwd, NWAVES * 64, LDS_BYTES) != hipSuccess || per_cu < 1) { fprintf(stderr, "kernel_launch: occupancy query says %d\n", per_cu); (void)hipGetLastError(); grid = -1; return; }
        grid = cus;
    }
    if (grid < 0) return;
    if (hipMemsetAsync((char*)d_ws + WS_CTL, 0, CTL_ZERO_BYTES, stream) != hipSuccess) return;
    Args a{};
    for (int i = 0; i < 21; ++i) a.in[i] = (const float*)d_in[i];
    a.out = (float*)d_out; a.ws = (unsigned char*)d_ws;
#if MK_PER_PHASE
    for (int p = 0; p < N_PHASES; ++p) {
        if (p >= 1) { const int l = (p - 1) / PH_PER_LAYER, k = (p - 1) % PH_PER_LAYER; if ((l & 1) == 0 && k >= 6) continue; }
        a.ph_lo = p; a.ph_hi = p + 1;
        hipLaunchKernelGGL(trunk_fwd, dim3(grid), dim3(NWAVES * 64), LDS_BYTES, stream, a);
    }
#else
    a.ph_lo = 0; a.ph_hi = N_PHASES;
    hipLaunchKernelGGL(trunk_fwd, dim3(grid), dim3(NWAVES * 64), LDS_BYTES, stream, a);
#endif
}
```

```cpp
#include <hip/hip_runtime.h>
#include <cstdio>
#include <cstdint>

#define MOE0_F8 1
#define DENSE_F2_F8_MASK 1
#define DENSE_F8_MASK 2
#ifndef MK_PER_PHASE
#define MK_PER_PHASE 0
#endif

namespace pg8 {
#define PG8_LAS __attribute__((address_space(3)))
typedef unsigned short bf16_t;
typedef short bf16x8 __attribute__((ext_vector_type(8)));
typedef float f32x4 __attribute__((ext_vector_type(4)));
typedef unsigned u32x4 __attribute__((ext_vector_type(4)));
typedef unsigned u32x2 __attribute__((ext_vector_type(2)));
constexpr int BM = 256, BK = 64, HALF = 128, HTB = HALF * BK * 2, STAGE_BYTES = 8 * HTB, NXCD = 8, WGM = 8;

__host__ __device__ __forceinline__ int lds_byte(int r, int c) { const int st = (r >> 4) * 2 + (c >> 5), rr = r & 15, cc = c & 31, ob = rr * 64 + cc * 2; return st * 1024 + (ob ^ (((ob >> 9) & 1) << 5)); }
__host__ __device__ __forceinline__ void stage_rc(int b, int& R, int& C) { const int st = b / 1024, sb = b % 1024, swz = sb ^ (((sb >> 9) & 1) << 5); R = (st >> 1) * 16 + swz / 64; C = (st & 1) * 32 + (swz % 64) / 2; }
__host__ __device__ __forceinline__ int perm32(int rho) { const int n = rho >> 4, i = rho & 15; return 8 * (i >> 2) + 4 * n + (i & 3); }

struct Unit { int pm, pn, pa; };
struct Gemm { const bf16_t* A; const bf16_t* Bt; int K; };

struct StaticOrder {
    int nM, nN, nwg, G, c;
    __host__ __device__ __forceinline__ void init(int nM_, int nN_, int G_, int c_) { nM = nM_; nN = nN_; nwg = nM * nN; G = G_; c = c_; }
    __host__ __device__ __forceinline__ bool next(int i, Unit& u) const {
        const long L = (long)i * G + c; if (L >= nwg) return false;
        int wgid = (int)L; { const int q = nwg / NXCD, r = nwg % NXCD, xcd = wgid % NXCD, off = wgid / NXCD; wgid = (xcd < r ? xcd * (q + 1) : r * (q + 1) + (xcd - r) * q) + off; }
        const int nig = WGM * nN, gid = wgid / nig, fm = gid * WGM, gsz = (nM - fm) < WGM ? (nM - fm) : WGM;
        u.pm = fm + ((wgid % nig) % gsz); u.pn = (wgid % nig) / gsz; u.pa = u.pm; return true;
    }
};

__device__ __forceinline__ unsigned cvt_pk_bf16(float lo, float hi) { unsigned r; asm volatile("v_cvt_pk_bf16_f32 %0, %1, %2" : "=v"(r) : "v"(lo), "v"(hi)); return r; }

typedef int i32x4 __attribute__((ext_vector_type(4)));
typedef int i32x8 __attribute__((ext_vector_type(8)));
template <bool F8, class Epi, class Sched>
__device__ __forceinline__ void gemm_phase(PG8_LAS unsigned char* lds, const Gemm g, const Sched& S, const Epi& E) {
    int tid_ = threadIdx.x; asm volatile("" : "+v"(tid_));
    const int tid = tid_, wid = __builtin_amdgcn_readfirstlane(tid >> 6), lane = tid & 63, wr = wid >> 2, wc = wid & 3, fr = lane & 15, fq = lane >> 4;
    int K_ = g.K; asm volatile("" : "+s"(K_));
    const int K = K_, nt = K / BK;
    unsigned voffA[2], voffB[2];
#pragma unroll
    for (int i = 0; i < 2; ++i) { int R, C; stage_rc(tid * 16 + i * 8192, R, C);
        voffA[i] = (unsigned)(R * K + C) * 2u; voffB[i] = (unsigned)(tid * 16 + i * 8192); }
    const size_t kstep = (size_t)(BK * 2);
    const size_t hstep = (size_t)HALF * K * 2;
    const size_t tstep = 2 * hstep;
    const size_t kstepB = 2 * HTB, hstepB = HTB;
    const unsigned ldsw = (unsigned)wid * 1024u;
    const int aoff = lds_byte(wr * 64 + fr, fq * 8), boff = lds_byte(wc * 32 + fr, fq * 8);
#define PG8_SA(b, h) (((b) * 2 + (h)) * HTB)
#define PG8_SB(b, h) ((4 + (b) * 2 + (h)) * HTB)
#define PG8_STAGE(bufoff, gbase, voff) do { _Pragma("unroll") for (int _i = 0; _i < 2; ++_i) \
        __builtin_amdgcn_global_load_lds((const unsigned*)((const char*)(gbase) + (voff)[_i]), (PG8_LAS unsigned*)(lds + (bufoff) + ldsw + _i * 8192), 16, 0, 0); } while (0)
#define PG8_LDA(dst, b, h) do { _Pragma("unroll") for (int m = 0; m < 4; ++m) { const bf16x8 x0_ = *(const PG8_LAS bf16x8*)(lds + PG8_SA(b, h) + aoff + m * 2048), x1_ = *(const PG8_LAS bf16x8*)(lds + PG8_SA(b, h) + aoff + m * 2048 + 1024); \
        if constexpr (F8) dst##8[m] = PG8_CAT(x0_, x1_); else { dst[m][0] = x0_; dst[m][1] = x1_; } } } while (0)
#define PG8_LDB(dst, b, h) do { _Pragma("unroll") for (int n = 0; n < 2; ++n) { const bf16x8 x0_ = *(const PG8_LAS bf16x8*)(lds + PG8_SB(b, h) + boff + n * 2048), x1_ = *(const PG8_LAS bf16x8*)(lds + PG8_SB(b, h) + boff + n * 2048 + 1024); \
        if constexpr (F8) dst##8[n] = PG8_CAT(x0_, x1_); else { dst[n][0] = x0_; dst[n][1] = x1_; } } } while (0)
#define PG8_CAT(x0, x1) __builtin_shufflevector(__builtin_bit_cast(i32x4, x0), __builtin_bit_cast(i32x4, x1), 0, 1, 2, 3, 4, 5, 6, 7)
#define PG8_MMA(ai, bj, At, Bt) do { __builtin_amdgcn_s_setprio(1); \
        if constexpr (F8) { _Pragma("unroll") for (int m = 0; m < 4; ++m) _Pragma("unroll") for (int n = 0; n < 2; ++n) \
            asm volatile("v_mfma_f32_16x16x128_f8f6f4 %0, %1, %2, %0" : "+v"(acc[ai][bj][m][n]) : "v"(Bt##8[n]), "v"(At##8[m])); } \
        else { _Pragma("unroll") for (int m = 0; m < 4; ++m) _Pragma("unroll") for (int n = 0; n < 2; ++n) _Pragma("unroll") for (int k = 0; k < 2; ++k) \
            acc[ai][bj][m][n] = __builtin_amdgcn_mfma_f32_16x16x32_bf16(Bt[n][k], At[m][k], acc[ai][bj][m][n], 0, 0, 0); } \
        __builtin_amdgcn_s_setprio(0); } while (0)
#define PG8_WAIT_V(n) asm volatile("s_waitcnt vmcnt(" #n ")" ::: "memory")
#define PG8_WAIT_L(n) asm volatile("s_waitcnt lgkmcnt(" #n ")" ::: "memory")
#define PG8_BAR __builtin_amdgcn_s_barrier()
#define PG8_SCHED __builtin_amdgcn_sched_barrier(0)
    Unit cur, nxt; int ui = 0;
    if (!S.next(0, cur)) return;
    f32x4 acc[2][2][4][2];
#pragma unroll
    for (int a = 0; a < 2; ++a)
#pragma unroll
        for (int b = 0; b < 2; ++b)
#pragma unroll
            for (int m = 0; m < 4; ++m)
#pragma unroll
                for (int n = 0; n < 2; ++n) acc[a][b][m][n] = (f32x4){0.f, 0.f, 0.f, 0.f};
    bf16x8 At[4][2], B0[2][2], B1[2][2]; i32x8 At8[4], B08[2], B18[2];
    const char* cA = (const char*)g.A + (size_t)cur.pa * tstep; const char* cB = (const char*)g.Bt + (size_t)cur.pn * tstep;
    PG8_STAGE(PG8_SB(0, 0), cB, voffB); PG8_STAGE(PG8_SB(0, 1), cB + hstepB, voffB); PG8_STAGE(PG8_SA(0, 0), cA, voffA); PG8_STAGE(PG8_SA(0, 1), cA + hstep, voffA);
    if (wr == 1) PG8_BAR;
    PG8_WAIT_V(2); PG8_BAR;
    PG8_STAGE(PG8_SB(1, 0), cB + kstepB, voffB); PG8_STAGE(PG8_SA(1, 0), cA + kstep, voffA); PG8_STAGE(PG8_SB(1, 1), cB + hstepB + kstepB, voffB);
    PG8_WAIT_V(6); PG8_BAR;
    for (;;) {
        const bool has_next = S.next(ui + 1, nxt);
        const char* nA = has_next ? (const char*)g.A + (size_t)nxt.pa * tstep : cA; const char* nB = has_next ? (const char*)g.Bt + (size_t)nxt.pn * tstep : cB;
#pragma clang loop unroll(disable)
        for (int t = 0; t < nt; t += 2) {
            const bool last = (t == nt - 2);
            const char* a1 = cA + (size_t)(t + 1) * kstep;
            const char* a2 = last ? nA : cA + (size_t)(t + 2) * kstep; const char* b2 = last ? nB : cB + (size_t)(t + 2) * kstepB;
            const char* a3 = a2 + kstep; const char* b3 = b2 + kstepB;
            PG8_LDB(B0, 0, 0); PG8_LDB(B1, 0, 1); PG8_SCHED; PG8_LDA(At, 0, 0); PG8_STAGE(PG8_SA(1, 1), a1 + hstep, voffA);
            PG8_WAIT_V(8); PG8_WAIT_L(0); PG8_BAR; PG8_MMA(0, 0, At, B0); PG8_MMA(0, 1, At, B1); PG8_BAR; PG8_SCHED;
            PG8_LDA(At, 0, 1); PG8_STAGE(PG8_SB(0, 0), b2, voffB); PG8_STAGE(PG8_SB(0, 1), b2 + hstepB, voffB); PG8_STAGE(PG8_SA(0, 0), a2, voffA);
            PG8_WAIT_V(8); PG8_WAIT_L(0); PG8_BAR; PG8_MMA(1, 0, At, B0); PG8_MMA(1, 1, At, B1); PG8_BAR; PG8_SCHED;
            PG8_LDB(B0, 1, 0); PG8_LDB(B1, 1, 1); PG8_SCHED; PG8_LDA(At, 1, 0); PG8_STAGE(PG8_SA(0, 1), a2 + hstep, voffA);
            PG8_WAIT_V(8); PG8_WAIT_L(0); PG8_BAR; PG8_MMA(0, 0, At, B0); PG8_MMA(0, 1, At, B1); PG8_BAR; PG8_SCHED;
            PG8_LDA(At, 1, 1); PG8_STAGE(PG8_SB(1, 0), b3, voffB); PG8_STAGE(PG8_SB(1, 1), b3 + hstepB, voffB); PG8_STAGE(PG8_SA(1, 0), a3, voffA);
            PG8_WAIT_V(8); PG8_WAIT_L(0); PG8_BAR; PG8_MMA(1, 0, At, B0); PG8_MMA(1, 1, At, B1); PG8_BAR; PG8_SCHED;
        }
        if (wr == 0) PG8_BAR;
        if constexpr (F8) asm volatile("s_nop 15\n\ts_nop 15" ::: "memory");
        E(acc, cur, wr, wc, fr, fq);
        if (!has_next) break;
        if (E.zero_after(cur)) {
#pragma unroll
        for (int a = 0; a < 2; ++a)
#pragma unroll
            for (int b = 0; b < 2; ++b)
#pragma unroll
                for (int m = 0; m < 4; ++m)
#pragma unroll
                    for (int n = 0; n < 2; ++n) acc[a][b][m][n] = (f32x4){0.f, 0.f, 0.f, 0.f};
        }
        cur = nxt; cA = nA; cB = nB; ++ui;
        if (wr == 1) PG8_BAR;
    }
    PG8_WAIT_V(0);
    PG8_BAR;
#undef PG8_SA
#undef PG8_SB
#undef PG8_STAGE
#undef PG8_LDA
#undef PG8_LDB
#undef PG8_MMA
#undef PG8_CAT
#undef PG8_WAIT_V
#undef PG8_WAIT_L
#undef PG8_BAR
#undef PG8_SCHED
}

template <class Epi, class Sched>
__device__ __forceinline__ void gemm_phase_mixed(PG8_LAS unsigned char* lds, const bf16_t* A16, const bf16_t* B16, const unsigned char* A8, const unsigned char* B8, int nproj, const Sched& S, const Epi& E) {
    int tid_ = threadIdx.x; asm volatile("" : "+v"(tid_));
    const int tid = tid_, wid = __builtin_amdgcn_readfirstlane(tid >> 6), lane = tid & 63, wr = wid >> 2, wc = wid & 3, fr = lane & 15, fq = lane >> 4;
    int K_ = 1024; asm volatile("" : "+s"(K_));
    const int K = K_;
    unsigned voffA[2], voffB[2];
#pragma unroll
    for (int i = 0; i < 2; ++i) { int R, C; stage_rc(tid * 16 + i * 8192, R, C);
        voffA[i] = (unsigned)(R * K + C) * 2u; voffB[i] = (unsigned)(tid * 16 + i * 8192); }
    const size_t kstep = (size_t)(BK * 2);
    const size_t hstep16 = (size_t)HALF * K * 2, hstep8 = hstep16 >> 1;
    const size_t kstepB = 2 * HTB, hstepB = HTB;
    const unsigned ldsw = (unsigned)wid * 1024u;
    const int aoff = lds_byte(wr * 64 + fr, fq * 8), boff = lds_byte(wc * 32 + fr, fq * 8);
#define PG8_SA(b, h) (((b) * 2 + (h)) * HTB)
#define PG8_SB(b, h) ((4 + (b) * 2 + (h)) * HTB)
#define MX_OFF(v, f8) ((f8) ? (((v) >> 1) + (((v) & 127u) >> 1)) : (v))
#define PG8_STAGE(bufoff, gbase, voff, f8) do { _Pragma("unroll") for (int _i = 0; _i < 2; ++_i) \
        __builtin_amdgcn_global_load_lds((const unsigned*)((const char*)(gbase) + MX_OFF((voff)[_i], f8)), (PG8_LAS unsigned*)(lds + (bufoff) + ldsw + _i * 8192), 16, 0, 0); } while (0)
#define PG8_CAT(x0, x1) __builtin_shufflevector(__builtin_bit_cast(i32x4, x0), __builtin_bit_cast(i32x4, x1), 0, 1, 2, 3, 4, 5, 6, 7)
#define PG8_LDA(F8K, dst, b, h) do { _Pragma("unroll") for (int m = 0; m < 4; ++m) { const bf16x8 x0_ = *(const PG8_LAS bf16x8*)(lds + PG8_SA(b, h) + aoff + m * 2048), x1_ = *(const PG8_LAS bf16x8*)(lds + PG8_SA(b, h) + aoff + m * 2048 + 1024); \
        if constexpr (F8K) dst##8[m] = PG8_CAT(x0_, x1_); else { dst[m][0] = x0_; dst[m][1] = x1_; } } } while (0)
#define PG8_LDB(F8K, dst, b, h) do { _Pragma("unroll") for (int n = 0; n < 2; ++n) { const bf16x8 x0_ = *(const PG8_LAS bf16x8*)(lds + PG8_SB(b, h) + boff + n * 2048), x1_ = *(const PG8_LAS bf16x8*)(lds + PG8_SB(b, h) + boff + n * 2048 + 1024); \
        if constexpr (F8K) dst##8[n] = PG8_CAT(x0_, x1_); else { dst[n][0] = x0_; dst[n][1] = x1_; } } } while (0)
#define PG8_MMA(F8K, ai, bj, At, Bt) do { __builtin_amdgcn_s_setprio(1); \
        if constexpr (F8K) { _Pragma("unroll") for (int m = 0; m < 4; ++m) _Pragma("unroll") for (int n = 0; n < 2; ++n) \
            asm volatile("v_mfma_f32_16x16x128_f8f6f4 %0, %1, %2, %0" : "+v"(acc[ai][bj][m][n]) : "v"(Bt##8[n]), "v"(At##8[m])); } \
        else { _Pragma("unroll") for (int m = 0; m < 4; ++m) _Pragma("unroll") for (int n = 0; n < 2; ++n) _Pragma("unroll") for (int k = 0; k < 2; ++k) \
            acc[ai][bj][m][n] = __builtin_amdgcn_mfma_f32_16x16x32_bf16(Bt[n][k], At[m][k], acc[ai][bj][m][n], 0, 0, 0); } \
        __builtin_amdgcn_s_setprio(0); } while (0)
#define PG8_WAIT_V(n) asm volatile("s_waitcnt vmcnt(" #n ")" ::: "memory")
#define PG8_WAIT_L(n) asm volatile("s_waitcnt lgkmcnt(" #n ")" ::: "memory")
#define PG8_BAR __builtin_amdgcn_s_barrier()
#define PG8_SCHED __builtin_amdgcn_sched_barrier(0)
#define MX_UNIT(u, f8, pa, pb, hs, ntv) do { f8 = (u).pn >= nproj; \
        pa = f8 ? (const char*)A8 + (size_t)(u).pm * (2 * hstep8) : (const char*)A16 + (size_t)(u).pm * (2 * hstep16); \
        pb = f8 ? (const char*)B8 + (size_t)((u).pn - nproj) * (2 * hstep8) : (const char*)B16 + (size_t)(u).pn * (2 * hstep16); \
        hs = f8 ? hstep8 : hstep16; ntv = f8 ? (K >> 7) : (K >> 6); } while (0)
#define MX_KLOOP(F8K) _Pragma("clang loop unroll(disable)") \
        for (int t = 0; t < cnt; t += 2) { \
            const bool last = (t == cnt - 2); \
            const char* a1 = cA + (size_t)(t + 1) * kstep; \
            const bool f2 = last ? nF8 : cF8; const size_t hs2 = last ? nhs : chs; \
            const char* a2 = last ? nA : cA + (size_t)(t + 2) * kstep; const char* b2 = last ? nB : cB + (size_t)(t + 2) * kstepB; \
            const char* a3 = a2 + kstep; const char* b3 = b2 + kstepB; \
            PG8_LDB(F8K, B0, 0, 0); PG8_LDB(F8K, B1, 0, 1); PG8_SCHED; PG8_LDA(F8K, At, 0, 0); PG8_STAGE(PG8_SA(1, 1), a1 + chs, voffA, cF8); \
            PG8_WAIT_V(8); PG8_WAIT_L(0); PG8_BAR; PG8_MMA(F8K, 0, 0, At, B0); PG8_MMA(F8K, 0, 1, At, B1); PG8_BAR; PG8_SCHED; \
            PG8_LDA(F8K, At, 0, 1); PG8_STAGE(PG8_SB(0, 0), b2, voffB, false); PG8_STAGE(PG8_SB(0, 1), b2 + hstepB, voffB, false); PG8_STAGE(PG8_SA(0, 0), a2, voffA, f2); \
            PG8_WAIT_V(8); PG8_WAIT_L(0); PG8_BAR; PG8_MMA(F8K, 1, 0, At, B0); PG8_MMA(F8K, 1, 1, At, B1); PG8_BAR; PG8_SCHED; \
            PG8_LDB(F8K, B0, 1, 0); PG8_LDB(F8K, B1, 1, 1); PG8_SCHED; PG8_LDA(F8K, At, 1, 0); PG8_STAGE(PG8_SA(0, 1), a2 + hs2, voffA, f2); \
            PG8_WAIT_V(8); PG8_WAIT_L(0); PG8_BAR; PG8_MMA(F8K, 0, 0, At, B0); PG8_MMA(F8K, 0, 1, At, B1); PG8_BAR; PG8_SCHED; \
            PG8_LDA(F8K, At, 1, 1); PG8_STAGE(PG8_SB(1, 0), b3, voffB, false); PG8_STAGE(PG8_SB(1, 1), b3 + hstepB, voffB, false); PG8_STAGE(PG8_SA(1, 0), a3, voffA, f2); \
            PG8_WAIT_V(8); PG8_WAIT_L(0); PG8_BAR; PG8_MMA(F8K, 1, 0, At, B0); PG8_MMA(F8K, 1, 1, At, B1); PG8_BAR; PG8_SCHED; \
        }
    Unit cur, nxt; int ui = 0;
    if (!S.next(0, cur)) return;
    f32x4 acc[2][2][4][2];
#pragma unroll
    for (int a = 0; a < 2; ++a)
#pragma unroll
        for (int b = 0; b < 2; ++b)
#pragma unroll
            for (int m = 0; m < 4; ++m)
#pragma unroll
                for (int n = 0; n < 2; ++n) acc[a][b][m][n] = (f32x4){0.f, 0.f, 0.f, 0.f};
    bf16x8 At[4][2], B0[2][2], B1[2][2]; i32x8 At8[4], B08[2], B18[2];
    bool cF8; const char* cA; const char* cB; size_t chs; int cnt;
    MX_UNIT(cur, cF8, cA, cB, chs, cnt);
    PG8_STAGE(PG8_SB(0, 0), cB, voffB, false); PG8_STAGE(PG8_SB(0, 1), cB + hstepB, voffB, false); PG8_STAGE(PG8_SA(0, 0), cA, voffA, cF8); PG8_STAGE(PG8_SA(0, 1), cA + chs, voffA, cF8);
    if (wr == 1) PG8_BAR;
    PG8_WAIT_V(2); PG8_BAR;
    PG8_STAGE(PG8_SB(1, 0), cB + kstepB, voffB, false); PG8_STAGE(PG8_SA(1, 0), cA + kstep, voffA, cF8); PG8_STAGE(PG8_SB(1, 1), cB + hstepB + kstepB, voffB, false);
    PG8_WAIT_V(6); PG8_BAR;
    for (;;) {
        const bool has_next = S.next(ui + 1, nxt);
        bool nF8 = cF8; const char* nA = cA; const char* nB = cB; size_t nhs = chs; int nnt = cnt;
        if (has_next) MX_UNIT(nxt, nF8, nA, nB, nhs, nnt);
        if (cF8) { MX_KLOOP(true) } else { MX_KLOOP(false) }
        if (wr == 0) PG8_BAR;
        asm volatile("s_nop 15\n\ts_nop 15" ::: "memory");
        E(acc, cur, wr, wc, fr, fq);
        if (!has_next) break;
#pragma unroll
        for (int a = 0; a < 2; ++a)
#pragma unroll
            for (int b = 0; b < 2; ++b)
#pragma unroll
                for (int m = 0; m < 4; ++m)
#pragma unroll
                    for (int n = 0; n < 2; ++n) acc[a][b][m][n] = (f32x4){0.f, 0.f, 0.f, 0.f};
        cur = nxt; cA = nA; cB = nB; cF8 = nF8; chs = nhs; cnt = nnt; ++ui;
        if (wr == 1) PG8_BAR;
    }
    PG8_WAIT_V(0);
    PG8_BAR;
#undef PG8_SA
#undef PG8_SB
#undef MX_OFF
#undef MX_UNIT
#undef MX_KLOOP
#undef PG8_STAGE
#undef PG8_LDA
#undef PG8_LDB
#undef PG8_MMA
#undef PG8_CAT
#undef PG8_WAIT_V
#undef PG8_WAIT_L
#undef PG8_BAR
#undef PG8_SCHED
}
}

constexpr int M = 16384, D = 1024, NL = 4, NWAVES = 8;
constexpr int IN_COLS = 7936, PROJ_COLS = 3840, GATE_COLS = 4096, FF = 2816, NE = 8;
constexpr int PC_Q = 0, PC_K = 512, PC_V = 640, PC_CB = 768, PC_CC = 1280, PC_CX = 1792, PC_P = 2304, PC_U = 2816, PC_SV = 3328;
constexpr int MAXROWS = 34816;
constexpr float RMS_EPS = 1e-6f;
constexpr float LOG2E = 1.4426950408889634f;
constexpr float W8_SCALE = 64.0f;
constexpr float A8_SCALE = 8.0f;

constexpr size_t MiB = 1u << 20;
constexpr size_t WS_CTL = 0, CTL_ZERO_BYTES = 1 * MiB;
constexpr size_t WS_WIN = 1 * MiB;
constexpr size_t WS_WIN8 = 31 * MiB;
constexpr size_t WS_X8 = 47 * MiB;
constexpr size_t WS_WBR = 63 * MiB;
constexpr size_t WS_WOUT = 79 * MiB;
constexpr size_t WS_DGU = 87 * MiB;
constexpr size_t WS_DD = 109 * MiB;
constexpr size_t WS_MGU = 120 * MiB;
constexpr size_t WS_MD = 296 * MiB;
constexpr size_t WS_PWT = 384 * MiB;
constexpr size_t WS_SW = 384 * MiB + 512 * 1024;
constexpr size_t WS_X = 385 * MiB;
constexpr size_t WS_XB = 449 * MiB;
constexpr size_t WS_SS = 481 * MiB;
constexpr size_t WS_TOK = 482 * MiB;
constexpr size_t WS_PROJ = 483 * MiB;
constexpr size_t WS_MRG32 = 483 * MiB;
constexpr size_t WS_MRG = 547 * MiB;
constexpr size_t WS_G = 603 * MiB;
constexpr size_t WS_BR = 731 * MiB;
constexpr size_t WS_ACT = 483 * MiB;
constexpr size_t WS_XG = 577 * MiB;
constexpr size_t WS_Y = 738 * MiB;
constexpr size_t WS_END = 806 * MiB;
static_assert(WS_ACT + (size_t)M * FF * 2 <= WS_XG && WS_ACT + (size_t)MAXROWS * FF <= WS_XG && WS_XG + (size_t)8 * 16384 * D <= WS_Y && WS_Y + (size_t)MAXROWS * D * 2 <= WS_END, "ws map");
static_assert(WS_MRG32 + (size_t)M * D * 4 <= WS_MRG && WS_MRG + (size_t)M * D * 2 <= WS_G && WS_PROJ + (size_t)M * PROJ_COLS * 2 <= WS_G, "ws map 2");
constexpr int CW_TMO = 0;
constexpr int CW_BAR = 4096;
constexpr int CW_CNT = 8192;

constexpr int RING_BYTES = 131072;
constexpr int MISC_OFF = RING_BYTES + 320;
constexpr int RSL_OFF = RING_BYTES + 1024;
constexpr int LDS_BYTES = 147456;

#define GAS __attribute__((address_space(1)))
#define LAS __attribute__((address_space(3)))
typedef unsigned short bf16;
typedef unsigned v4u __attribute__((ext_vector_type(4)));
typedef unsigned v2u __attribute__((ext_vector_type(2)));
typedef float f32x4 __attribute__((ext_vector_type(4)));
typedef short bf16x8 __attribute__((ext_vector_type(8)));
typedef short s16x4 __attribute__((ext_vector_type(4)));
#define LDS_WAIT() asm volatile("s_waitcnt lgkmcnt(0)" ::: "memory")
__device__ __forceinline__ float bf2f(unsigned short b) { return __uint_as_float(((unsigned)b) << 16); }
__device__ __forceinline__ float bflo(unsigned w) { return __uint_as_float(w << 16); }
__device__ __forceinline__ float bfhi(unsigned w) { return __uint_as_float(w & 0xffff0000u); }
__device__ __forceinline__ unsigned pk2(float lo, float hi) { return pg8::cvt_pk_bf16(lo, hi); }
__device__ __forceinline__ unsigned pk4_fp8(float a, float b, float c, float d) { int w = 0; w = __builtin_amdgcn_cvt_pk_fp8_f32(a, b, w, false); w = __builtin_amdgcn_cvt_pk_fp8_f32(c, d, w, true); return (unsigned)w; }
__device__ __forceinline__ float fast_sigmoid(float v) { return __builtin_amdgcn_rcpf(1.0f + __builtin_amdgcn_exp2f(-v * LOG2E)); }
#define WS_DPP(x, ctrl, rmask) __int_as_float(__builtin_amdgcn_update_dpp(0, __float_as_int(x), ctrl, rmask, 0xF, false))
__device__ __forceinline__ float rows_sum(float v) {
    { const auto r = __builtin_amdgcn_permlane16_swap(__float_as_uint(v), __float_as_uint(v), false, false); v = __uint_as_float(r[0]) + __uint_as_float(r[1]); }
    { const auto r = __builtin_amdgcn_permlane32_swap(__float_as_uint(v), __float_as_uint(v), false, false); v = __uint_as_float(r[0]) + __uint_as_float(r[1]); }
    return v;
}
__device__ __forceinline__ float rows_max(float v) {
    { const auto r = __builtin_amdgcn_permlane16_swap(__float_as_uint(v), __float_as_uint(v), false, false); v = fmaxf(__uint_as_float(r[0]), __uint_as_float(r[1])); }
    { const auto r = __builtin_amdgcn_permlane32_swap(__float_as_uint(v), __float_as_uint(v), false, false); v = fmaxf(__uint_as_float(r[0]), __uint_as_float(r[1])); }
    return v;
}
__device__ __forceinline__ float wave_sum(float v) {
    v += WS_DPP(v, 0xB1, 0xF);
    v += WS_DPP(v, 0x4E, 0xF);
    v += WS_DPP(v, 0x141, 0xF);
    v += WS_DPP(v, 0x140, 0xF);
    v += WS_DPP(v, 0x142, 0xA);
    v += WS_DPP(v, 0x143, 0xC);
    return __int_as_float(__builtin_amdgcn_readlane(__float_as_int(v), 63));
}

#define XB_TMO      128
#define XB_XCNT(j)  (256  + 64 * (j))
#define XB_XSUB(j)  (1280 + 64 * (j))
#define XB_XGEN(j)  (2304 + 64 * (j))
#define XB_TOP      3328
#define XB_TOPGEN   3392
#define XCD_BAR_WORDS 3456
#define XB_SPIN_CAP (1u << 18)
__device__ __forceinline__ unsigned xb_ld(unsigned* p)              { return __hip_atomic_load(p, __ATOMIC_RELAXED, __HIP_MEMORY_SCOPE_AGENT); }
__device__ __forceinline__ unsigned xb_add(unsigned* p, unsigned v) { return __hip_atomic_fetch_add(p, v, __ATOMIC_RELAXED, __HIP_MEMORY_SCOPE_AGENT); }
__device__ __forceinline__ unsigned xb_xcc_id() { return (unsigned)__builtin_amdgcn_s_getreg((3 << 11) | 20) & 0xFu; }
#define XB_SPIN(cond, bar) do { unsigned _sp = 0; while (cond) { __builtin_amdgcn_s_sleep(1); \
    if ((++_sp & 255u) == 0u) { if (xb_ld(&(bar)[XB_TMO])) break; if (_sp > XB_SPIN_CAP) { atomicAdd(&(bar)[XB_TMO], 1u); break; } } } } while (0)
struct XcdBarrier { unsigned* bar; unsigned x; volatile LAS unsigned* st; };
__device__ __forceinline__ XcdBarrier xcd_barrier_post(unsigned* bar, volatile LAS unsigned* st) {
    XcdBarrier b; b.bar = bar; b.x = xb_xcc_id(); b.st = st;
    if (threadIdx.x == 0) (void)xb_add(&bar[XB_XCNT(b.x)], 1u);
    return b;
}
__device__ __forceinline__ void xcd_barrier_complete(unsigned* bar, unsigned x, unsigned& nloc, unsigned& nx) {
    const unsigned G = gridDim.x * gridDim.y * gridDim.z;
    unsigned sum, cnt, mine, sp = 0u;
    for (;;) {
        sum = 0u; cnt = 0u; mine = 0u;
#pragma unroll
        for (unsigned j = 0; j < 16; ++j) { const unsigned c = xb_ld(&bar[XB_XCNT(j)]); sum += c; cnt += (c > 0u) ? 1u : 0u; mine = (j == x) ? c : mine; }
        if (sum == G) break;
        __builtin_amdgcn_s_sleep(1);
        if ((++sp & 255u) == 0u) { if (xb_ld(&bar[XB_TMO])) break; if (sp > XB_SPIN_CAP) { atomicAdd(&bar[XB_TMO], 1u); break; } }
    }
    nloc = mine > 0u ? mine : 1u; nx = cnt > 0u ? cnt : 1u;
}
__device__ __forceinline__ void xcd_barrier(const XcdBarrier& b) {
    asm volatile("s_waitcnt vmcnt(0)" ::: "memory");
    __syncthreads();
    if (threadIdx.x == 0) {
        unsigned* bar = b.bar;
        __builtin_amdgcn_s_waitcnt(0);
        unsigned nloc = b.st[0], nx = b.st[1];
        if (nloc == 0u) { xcd_barrier_complete(bar, b.x, nloc, nx); b.st[0] = nloc; b.st[1] = nx; }
        const unsigned old = xb_add(&bar[XB_XSUB(b.x)], 1u);
        const unsigned gen = old / nloc;
        if (old + 1u == (gen + 1u) * nloc) {
            __builtin_amdgcn_fence(__ATOMIC_RELEASE, "agent");
            asm volatile("s_waitcnt vmcnt(0)" ::: "memory");
            const unsigned og = xb_add(&bar[XB_TOP], 1u);
            const unsigned tg = og / nx;
            if (og + 1u == (tg + 1u) * nx) xb_add(&bar[XB_TOPGEN], 1u);
            else XB_SPIN(xb_ld(&bar[XB_TOPGEN]) == tg, bar);
            __builtin_amdgcn_fence(__ATOMIC_ACQUIRE, "agent");
            xb_add(&bar[XB_XGEN(b.x)], 1u);
            asm volatile("s_waitcnt vmcnt(0)" ::: "memory");
        } else {
            XB_SPIN(xb_ld(&bar[XB_XGEN(b.x)]) == gen, bar);
            __builtin_amdgcn_fence(__ATOMIC_ACQUIRE, "agent");
            asm volatile("s_waitcnt vmcnt(0)" ::: "memory");
        }
    }
    __syncthreads();
}

using pg8::Unit;
__device__ __forceinline__ float row_rscale(const float* SS, int row) {
    const f32x4 a = *(const f32x4*)(SS + (size_t)row * 4), b = *(const f32x4*)(SS + ((size_t)M + row) * 4), c = *(const f32x4*)(SS + ((size_t)2 * M + row) * 4), d = *(const f32x4*)(SS + ((size_t)3 * M + row) * 4);
    const float s = ((a[0] + a[1]) + (a[2] + a[3])) + ((b[0] + b[1]) + (b[2] + b[3])) + ((c[0] + c[1]) + (c[2] + c[3])) + ((d[0] + d[1]) + (d[2] + d[3]));
    return 1.0f / sqrtf(s * (1.0f / D) + RMS_EPS);
}
__device__ __forceinline__ unsigned gate_frag_off(int pm, int gt, int wave, int am, int lane) { return (unsigned)((((pm * 16 + gt) * 8 + wave) * 8 + am) * 1024 + lane * 16); }
struct EpiG1 {
    __device__ __forceinline__ bool zero_after(const Unit&) const { return true; }
    bf16* PROJ; bf16* G; const float* SS; const LAS float* RSL; int pm0;
    __device__ __forceinline__ void operator()(const f32x4 (&acc)[2][2][4][2], const Unit& u, int wr, int wc, int fr, int fq) const {
        const int row0 = u.pm * 256 + wr * 64 + fr;
        const bool gate = u.pn >= 15;
        float rs[2][4];
        if (u.pm == pm0) {
#pragma unroll
            for (int ai = 0; ai < 2; ++ai)
#pragma unroll
                for (int m = 0; m < 4; ++m) rs[ai][m] = RSL[ai * 128 + wr * 64 + m * 16 + fr];
        } else {
#pragma unroll
            for (int ai = 0; ai < 2; ++ai)
#pragma unroll
                for (int m = 0; m < 4; ++m) rs[ai][m] = row_rscale(SS, row0 + ai * 128 + m * 16);
        }
#pragma unroll
        for (int ai = 0; ai < 2; ++ai)
#pragma unroll
            for (int m = 0; m < 4; ++m) { const int row = row0 + ai * 128 + m * 16; const float r = rs[ai][m];
                if (gate) {
                    unsigned w4[4];
                    const float kr = r * (-LOG2E / W8_SCALE);
#pragma unroll
                    for (int bj = 0; bj < 2; ++bj) { unsigned lo = 0u, hi = 0u;
#define GATE8(x) fmaxf(__builtin_rintf(__builtin_amdgcn_rcpf(__builtin_fmaf(__builtin_amdgcn_exp2f((x) * kr), 1.0f / 255.0f, 1.0f / 255.0f))), 1.0f)
                        lo = __builtin_amdgcn_cvt_pk_u8_f32(GATE8(acc[ai][bj][m][0][0]), 0, lo); lo = __builtin_amdgcn_cvt_pk_u8_f32(GATE8(acc[ai][bj][m][0][1]), 1, lo);
                        lo = __builtin_amdgcn_cvt_pk_u8_f32(GATE8(acc[ai][bj][m][0][2]), 2, lo); lo = __builtin_amdgcn_cvt_pk_u8_f32(GATE8(acc[ai][bj][m][0][3]), 3, lo);
                        hi = __builtin_amdgcn_cvt_pk_u8_f32(GATE8(acc[ai][bj][m][1][0]), 0, hi); hi = __builtin_amdgcn_cvt_pk_u8_f32(GATE8(acc[ai][bj][m][1][1]), 1, hi);
                        hi = __builtin_amdgcn_cvt_pk_u8_f32(GATE8(acc[ai][bj][m][1][2]), 2, hi); hi = __builtin_amdgcn_cvt_pk_u8_f32(GATE8(acc[ai][bj][m][1][3]), 3, hi);
#undef GATE8
                        w4[2 * bj] = lo; w4[2 * bj + 1] = hi; }
                    *(v4u*)((unsigned char*)G + gate_frag_off(u.pm, u.pn - 15, wr * 4 + wc, ai * 4 + m, fq * 16 + fr)) = (v4u){w4[0], w4[1], w4[2], w4[3]};
                } else {
                    bf16* rowp = PROJ + (size_t)row * PROJ_COLS + u.pn * 256 + wc * 32 + 8 * fq;
#pragma unroll
                    for (int bj = 0; bj < 2; ++bj) { const f32x4 v0 = acc[ai][bj][m][0] * r, v1 = acc[ai][bj][m][1] * r;
                        v4u w; w.x = pk2(v0[0], v0[1]); w.y = pk2(v0[2], v0[3]); w.z = pk2(v1[0], v1[1]); w.w = pk2(v1[2], v1[3]);
                        *(v4u*)(rowp + bj * 128) = w; } } }
    }
};
struct EpiB1 {
    const unsigned char* G8; bf16* MRG;
    __device__ __forceinline__ bool zero_after(const Unit& u) const { return (u.pn >> 2) == 3; }
    __device__ __forceinline__ void operator()(f32x4 (&acc)[2][2][4][2], const Unit& u, int wr, int wc, int fr, int fq) const {
        const int n = u.pn >> 2, pn = u.pn & 3, pm = u.pm & 63;
        const int row0 = pm * 256 + wr * 64 + fr, col0 = pn * 256 + wc * 32 + 8 * fq;
        v4u ga[2][4], gb[2][4];
        { const unsigned char* gp = G8 + gate_frag_off(pm, n * 4 + pn, wr * 4 + wc, 0, fq * 16 + fr);
#pragma unroll
          for (int ai = 0; ai < 2; ++ai)
#pragma unroll
            for (int m = 0; m < 4; ++m) { ga[ai][m] = *(const v4u*)(gp + (ai * 4 + m) * 1024); if (n < 3) gb[ai][m] = *(const v4u*)(gp + 4 * 65536 + (ai * 4 + m) * 1024); } }
#pragma unroll
        for (int ai = 0; ai < 2; ++ai) {
#pragma unroll
            for (int m = 0; m < 4; ++m)
#pragma unroll
                for (int bj = 0; bj < 2; ++bj) {
                    float f[8];
#pragma unroll
                    for (int j = 0; j < 8; ++j) { const unsigned wa = bj == 0 ? (j < 4 ? ga[ai][m].x : ga[ai][m].y) : (j < 4 ? ga[ai][m].z : ga[ai][m].w); const float num = (float)((wa >> (8 * (j & 3))) & 0xffu);
                        if (n < 3) { const unsigned wb = bj == 0 ? (j < 4 ? gb[ai][m].x : gb[ai][m].y) : (j < 4 ? gb[ai][m].z : gb[ai][m].w); f[j] = num * __builtin_amdgcn_rcpf((float)((wb >> (8 * (j & 3))) & 0xffu)); }
                        else f[j] = num * (1.0f / 255.0f); }
                    f32x4 v0 = acc[ai][bj][m][0], v1 = acc[ai][bj][m][1];
                    v0[0] *= f[0]; v0[1] *= f[1]; v0[2] *= f[2]; v0[3] *= f[3]; v1[0] *= f[4]; v1[1] *= f[5]; v1[2] *= f[6]; v1[3] *= f[7];
                    if (n < 3) { acc[ai][bj][m][0] = v0; acc[ai][bj][m][1] = v1; }
                    else { v4u w; w.x = pk2(v0[0], v0[1]); w.y = pk2(v0[2], v0[3]); w.z = pk2(v1[0], v1[1]); w.w = pk2(v1[2], v1[3]);
                        *(v4u*)(MRG + (size_t)(row0 + ai * 128 + m * 16) * D + col0 + bj * 128) = w; } }
        }
    }
};
template <bool W8, bool SC8> struct EpiRes {
    __device__ __forceinline__ bool zero_after(const Unit&) const { return true; }
    bf16* XB; float* SS; unsigned char* X8;
    static constexpr float scale = SC8 ? 1.0f / (W8_SCALE * A8_SCALE) : 1.0f;
    __device__ __forceinline__ void operator()(const f32x4 (&acc)[2][2][4][2], const Unit& u, int wr, int wc, int fr, int fq) const {
        const int row0 = u.pm * 256 + wr * 64 + fr, col0 = u.pn * 256 + wc * 32 + 8 * fq;
#pragma unroll
        for (int ai = 0; ai < 2; ++ai) {
            v4u xv[4][2];
#pragma unroll
            for (int m = 0; m < 4; ++m)
#pragma unroll
                for (int bj = 0; bj < 2; ++bj) xv[m][bj] = *(const v4u*)(XB + (size_t)(row0 + ai * 128 + m * 16) * D + col0 + bj * 128);
#pragma unroll
            for (int m = 0; m < 4; ++m) { const int row = row0 + ai * 128 + m * 16; float s = 0.f;
#pragma unroll
                for (int bj = 0; bj < 2; ++bj) { const size_t off = (size_t)row * D + col0 + bj * 128; const v4u xa = xv[m][bj];
                    const f32x4 x0 = (f32x4){bflo(xa.x), bfhi(xa.x), bflo(xa.y), bfhi(xa.y)}, x1 = (f32x4){bflo(xa.z), bfhi(xa.z), bflo(xa.w), bfhi(xa.w)};
                    const f32x4 v0 = x0 + acc[ai][bj][m][0] * scale, v1 = x1 + acc[ai][bj][m][1] * scale;
                    { v4u w; w.x = pk2(v0[0], v0[1]); w.y = pk2(v0[2], v0[3]); w.z = pk2(v1[0], v1[1]); w.w = pk2(v1[2], v1[3]); *(v4u*)(XB + off) = w; }
                    if (W8 && X8) { v2u w8; w8.x = pk4_fp8(v0[0], v0[1], v0[2], v0[3]); w8.y = pk4_fp8(v1[0], v1[1], v1[2], v1[3]); *(v2u*)(X8 + off) = w8; }
                    s += (v0[0] * v0[0] + v0[1] * v0[1]) + (v0[2] * v0[2] + v0[3] * v0[3]) + (v1[0] * v1[0] + v1[1] * v1[1]) + (v1[2] * v1[2] + v1[3] * v1[3]); }
                s = rows_sum(s);
                if (fq == 0) SS[((size_t)u.pn * M + row) * 4 + wc] = s; }
            asm volatile("" ::: "memory");
        }
    }
};
template <bool SCALED, bool OUT8 = false> struct EpiGU {
    __device__ __forceinline__ bool zero_after(const Unit&) const { return true; }
    bf16* ACT; const float* SS; const LAS float* RSL; int pm0;
    __device__ __forceinline__ void operator()(const f32x4 (&acc)[2][2][4][2], const Unit& u, int wr, int wc, int fr, int fq) const {
        const int row0 = u.pm * 256 + wr * 64 + fr, col0 = (u.pn % 22) * 128 + wc * 32 + 8 * fq;
#pragma unroll
        for (int ai = 0; ai < 2; ++ai)
#pragma unroll
            for (int m = 0; m < 4; ++m) { const int row = row0 + ai * 128 + m * 16; const float r = SCALED ? (u.pm == pm0 ? RSL[ai * 128 + wr * 64 + m * 16 + fr] : row_rscale(SS, row)) : 1.0f;
                float o[8];
#pragma unroll
                for (int n = 0; n < 2; ++n)
#pragma unroll
                    for (int j = 0; j < 4; ++j) { const float gt = acc[ai][0][m][n][j] * r, up = acc[ai][1][m][n][j] * r; o[n * 4 + j] = gt * fast_sigmoid(gt) * up; }
                if (OUT8) {
#pragma unroll
                    for (int j = 0; j < 8; ++j) o[j] = __builtin_amdgcn_fmed3f(o[j] * A8_SCALE, -448.0f, 448.0f);
                    v2u w8; w8.x = pk4_fp8(o[0], o[1], o[2], o[3]); w8.y = pk4_fp8(o[4], o[5], o[6], o[7]);
                    *(v2u*)((unsigned char*)ACT + (size_t)row * FF + col0) = w8;
                } else {
                v4u w; w.x = pk2(o[0], o[1]); w.y = pk2(o[2], o[3]); w.z = pk2(o[4], o[5]); w.w = pk2(o[6], o[7]);
                *(v4u*)(ACT + (size_t)row * FF + col0) = w; } }
    }
};
struct EpiGU8 {
    __device__ __forceinline__ bool zero_after(const Unit&) const { return true; }
    unsigned char* ACT8; const LAS float* RSL; const float* SS; int pm0;
    __device__ __forceinline__ void operator()(const f32x4 (&acc)[2][2][4][2], const Unit& u, int wr, int wc, int fr, int fq) const {
        const int row0 = u.pm * 256 + wr * 64 + fr, col0 = (u.pn % 22) * 128 + wc * 32 + 8 * fq;
#pragma unroll
        for (int ai = 0; ai < 2; ++ai)
#pragma unroll
            for (int m = 0; m < 4; ++m) { const int row = row0 + ai * 128 + m * 16; const float r = RSL ? (u.pm == pm0 ? RSL[ai * 128 + wr * 64 + m * 16 + fr] : row_rscale(SS, row)) : 1.0f;
                float o[8];
#pragma unroll
                for (int n = 0; n < 2; ++n)
#pragma unroll
                    for (int j = 0; j < 4; ++j) { const float gt = acc[ai][0][m][n][j] * (r * (1.0f / W8_SCALE)), up = acc[ai][1][m][n][j] * (r * (A8_SCALE / W8_SCALE)); o[n * 4 + j] = gt * fast_sigmoid(gt) * up; }
#pragma unroll
                for (int j = 0; j < 8; ++j) o[j] = __builtin_amdgcn_fmed3f(o[j], -448.0f, 448.0f);
                v2u w; w.x = pk4_fp8(o[0], o[1], o[2], o[3]); w.y = pk4_fp8(o[4], o[5], o[6], o[7]);
                *(v2u*)(ACT8 + (size_t)row * FF + col0) = w; }
    }
};
struct EpiY {
    __device__ __forceinline__ bool zero_after(const Unit&) const { return true; }
    bf16* Y; float scale;
    __device__ __forceinline__ void operator()(const f32x4 (&acc)[2][2][4][2], const Unit& u, int wr, int wc, int fr, int fq) const {
        const int row0 = u.pm * 256 + wr * 64 + fr, col0 = (u.pn & 3) * 256 + wc * 32 + 8 * fq;
#pragma unroll
        for (int ai = 0; ai < 2; ++ai)
#pragma unroll
            for (int m = 0; m < 4; ++m) { bf16* rowp = Y + (size_t)(row0 + ai * 128 + m * 16) * D + col0;
#pragma unroll
                for (int bj = 0; bj < 2; ++bj) { const f32x4 v0 = acc[ai][bj][m][0] * scale, v1 = acc[ai][bj][m][1] * scale;
                    v4u w; w.x = pk2(v0[0], v0[1]); w.y = pk2(v0[2], v0[3]); w.z = pk2(v1[0], v1[1]); w.w = pk2(v1[2], v1[3]);
                    *(v4u*)(rowp + bj * 128) = w; } }
    }
};
struct B1Order {
    pg8::StaticOrder so;
    __device__ __forceinline__ bool next(int i, Unit& u) const { Unit q; if (!so.next(i >> 2, q)) return false; const int n = i & 3; u.pm = n * 64 + q.pm; u.pn = n * 4 + q.pn; u.pa = u.pm; return true; }
};
constexpr int XG_CAP = 16384, XG_CAP_TILES = XG_CAP / 256;
struct MoeOrder {
    pg8::StaticOrder so; int tb1, tb2, tb3, tb4, tb5, tb6, tb7; int nN; int fixedA;
    __device__ __forceinline__ bool next(int i, Unit& u) const { Unit q; if (!so.next(i, q)) return false;
        const int e = (q.pm >= tb1) + (q.pm >= tb2) + (q.pm >= tb3) + (q.pm >= tb4) + (q.pm >= tb5) + (q.pm >= tb6) + (q.pm >= tb7);
        int tbe = 0; tbe = e == 1 ? tb1 : tbe; tbe = e == 2 ? tb2 : tbe; tbe = e == 3 ? tb3 : tbe; tbe = e == 4 ? tb4 : tbe; tbe = e == 5 ? tb5 : tbe; tbe = e == 6 ? tb6 : tbe; tbe = e == 7 ? tb7 : tbe;
        u.pm = q.pm; u.pn = e * nN + q.pn; u.pa = fixedA ? e * XG_CAP_TILES + (q.pm - tbe) : q.pm; return true; }
};

struct Args { const float* in[21]; float* out; unsigned char* ws; int ph_lo, ph_hi; };
static_assert(sizeof(Args) == 21 * 8 + 8 + 8 + 8, "Args has no padding");
enum { IN_X = 0, IN_LNMIX, IN_WIN, IN_SINK, IN_CONVW, IN_POOLW, IN_POOLS, IN_SGUW, IN_SGUB, IN_WBR, IN_WOUT, IN_LNFFN, IN_DG, IN_DU, IN_DD, IN_RW, IN_RB, IN_MG, IN_MU, IN_MD, IN_LNF };
constexpr int PH_PER_LAYER = 9, N_PHASES = 1 + NL * PH_PER_LAYER;

__device__ __forceinline__ size_t btile_off(int drow, int kbyte, int Kbytes) {
    const int pn = drow >> 8, h = (drow >> 7) & 1, g = drow & 127, gl = g & 31;
    const int R = (g & ~31) + 16 * ((gl >> 2) & 1) + 4 * (gl >> 3) + (gl & 3);
    const int kt = kbyte >> 7, cb = kbyte & 127, st = (R >> 4) * 2 + (cb >> 6), ob = (R & 15) * 64 + (cb & 63);
    return ((size_t)((pn * (Kbytes >> 7) + kt) * 2 + h) << 14) + (size_t)(st * 1024 + (ob ^ (((ob >> 9) & 1) << 5)));
}
__device__ __forceinline__ void p0_item(const float* W, int K, int N, int n_lo, int ncols, bf16* WT, const float* gk, int il, int roff, int f8, LAS unsigned char* scr, int item, int lane, bool tm) {
    const int nblk = ncols >> 6, kb = item / nblk, nb = item - kb * nblk, k0 = kb * 64, n0 = nb * 64;
    const int r = lane >> 4, c4 = lane & 15;
    f32x4 v[16];
#pragma unroll
    for (int i = 0; i < 16; ++i) v[i] = *(const f32x4*)(W + (size_t)(k0 + 4 * i + r) * N + n_lo + n0 + 4 * c4);
    if (gk) {
#pragma unroll
        for (int i = 0; i < 16; ++i) v[i] = v[i] * gk[k0 + 4 * i + r]; }
    if (f8) {
#pragma unroll
        for (int i = 0; i < 16; ++i) v[i] = v[i] * W8_SCALE; }
#pragma unroll
    for (int i = 0; i < 16; ++i) { LAS unsigned* d = (LAS unsigned*)(scr + (4 * i + r) * 132 + c4 * 8); d[0] = pk2(v[i][0], v[i][1]); d[1] = pk2(v[i][2], v[i][3]); }
    LDS_WAIT(); asm volatile("" ::: "memory");
    const int c = lane & 7, nr = lane >> 3;
#pragma unroll
    for (int j = 0; j < 8; ++j) { const int n = 8 * j + nr;
        const LAS unsigned short* s = (const LAS unsigned short*)(scr + (8 * c) * 132 + n * 2);
        v4u o; o.x = (unsigned)s[0] | ((unsigned)s[66] << 16); o.y = (unsigned)s[2 * 66] | ((unsigned)s[3 * 66] << 16);
        o.z = (unsigned)s[4 * 66] | ((unsigned)s[5 * 66] << 16); o.w = (unsigned)s[6 * 66] | ((unsigned)s[7 * 66] << 16);
        const int ng = n0 + n; const int drow = il ? ((ng >> 7) * 256 + (ng & 127) + roff) : (ng + roff);
        if (f8) { v2u o8; o8.x = pk4_fp8(bflo(o.x), bfhi(o.x), bflo(o.y), bfhi(o.y)); o8.y = pk4_fp8(bflo(o.z), bfhi(o.z), bflo(o.w), bfhi(o.w));
            *(v2u*)((unsigned char*)WT + btile_off(drow, k0 + 8 * c, K)) = o8; }
        else if (tm) *(v4u*)((unsigned char*)WT + btile_off(drow, (k0 + 8 * c) * 2, K * 2)) = o;
        else *(v4u*)(WT + (size_t)drow * K + k0 + 8 * c) = o; }
    LDS_WAIT(); asm volatile("" ::: "memory");
}
__device__ __forceinline__ void att_unit(LAS unsigned char* lds, const bf16* PROJ, const float* sinks, bf16* BR0, int nb, int kvh) {
    constexpr int KP = 144, VP = 528, VT_OFF = 256 * KP;
    int tid_ = threadIdx.x; asm volatile("" : "+v"(tid_)); const int tid = tid_, lane = tid & 63, wave = __builtin_amdgcn_readfirstlane(tid >> 6);
    const int g4 = wave >> 1, qh = wave & 1, head = kvh * 4 + g4, fr = lane & 15, fg = lane >> 4;
    bf16x8 qfa[4][2];
#pragma unroll
    for (int qt = 0; qt < 4; ++qt) { const bf16* qp = PROJ + (size_t)(nb * 128 + qh * 64 + qt * 16 + fr) * PROJ_COLS + PC_Q + head * 64 + 8 * fg; qfa[qt][0] = *(const bf16x8*)qp; qfa[qt][1] = *(const bf16x8*)(qp + 32); }
    const float sink_t = sinks[head] * LOG2E;
    __syncthreads();
#pragma unroll
    for (int i = 0; i < 4; ++i) { const int q = tid + 512 * i, kj = q >> 3, c = q & 7; const int tk = nb * 128 - 128 + kj;
        v4u kv = (v4u){0u, 0u, 0u, 0u}, vv = (v4u){0u, 0u, 0u, 0u};
        if (tk >= 0) { const bf16* src = PROJ + (size_t)tk * PROJ_COLS + kvh * 64 + c * 8; kv = *(const v4u*)(src + PC_K); vv = *(const v4u*)(src + PC_V); }
        *(LAS v4u*)(lds + kj * KP + c * 16) = kv;
        LAS unsigned short* vt = (LAS unsigned short*)(lds + VT_OFF + (c * 8) * VP + kj * 2);
        vt[0 * (VP / 2)] = (unsigned short)(vv.x & 0xffffu); vt[1 * (VP / 2)] = (unsigned short)(vv.x >> 16);
        vt[2 * (VP / 2)] = (unsigned short)(vv.y & 0xffffu); vt[3 * (VP / 2)] = (unsigned short)(vv.y >> 16);
        vt[4 * (VP / 2)] = (unsigned short)(vv.z & 0xffffu); vt[5 * (VP / 2)] = (unsigned short)(vv.z >> 16);
        vt[6 * (VP / 2)] = (unsigned short)(vv.w & 0xffffu); vt[7 * (VP / 2)] = (unsigned short)(vv.w >> 16); }
    __syncthreads();
#pragma unroll
    for (int qt = 0; qt < 4; ++qt) {
        const int q0 = qh * 64 + qt * 16, qi = q0 + fr, tok = nb * 128 + qi, kb0 = (q0 >> 5);
        const bf16x8 qf0 = qfa[qt][0], qf1 = qfa[qt][1];
        f32x4 sc[5][2];
#pragma unroll
        for (int b = 0; b < 5; ++b)
#pragma unroll
            for (int h2 = 0; h2 < 2; ++h2) { const int key = 32 * (kb0 + b) + 16 * h2 + fr;
                const bf16x8 kf0 = *(const LAS bf16x8*)(lds + key * KP + 16 * fg), kf1 = *(const LAS bf16x8*)(lds + key * KP + 64 + 16 * fg);
                f32x4 s = (f32x4){0.f, 0.f, 0.f, 0.f};
                s = __builtin_amdgcn_mfma_f32_16x16x32_bf16(kf0, qf0, s, 0, 0, 0);
                s = __builtin_amdgcn_mfma_f32_16x16x32_bf16(kf1, qf1, s, 0, 0, 0);
                sc[b][h2] = s; }
        float mx = sink_t;
#pragma unroll
        for (int b = 0; b < 5; ++b)
#pragma unroll
            for (int h2 = 0; h2 < 2; ++h2)
#pragma unroll
                for (int j = 0; j < 4; ++j) { const int kj = 32 * (kb0 + b) + 16 * h2 + 4 * fg + j;
                    const bool valid = (kj > qi) && (kj <= qi + 128) && (nb > 0 || kj >= 128);
                    const float t = valid ? sc[b][h2][j] * (0.125f * LOG2E) : -1e30f; sc[b][h2][j] = t; mx = fmaxf(mx, t); }
        mx = rows_max(mx);
        float sum = 0.f;
#pragma unroll
        for (int b = 0; b < 5; ++b)
#pragma unroll
            for (int h2 = 0; h2 < 2; ++h2)
#pragma unroll
                for (int j = 0; j < 4; ++j) { const float p = __builtin_amdgcn_exp2f(sc[b][h2][j] - mx); sc[b][h2][j] = p; sum += p; }
        sum = rows_sum(sum);
        const float inv = 1.0f / (sum + __builtin_amdgcn_exp2f(sink_t - mx));
        f32x4 o[4];
#pragma unroll
        for (int dt = 0; dt < 4; ++dt) o[dt] = (f32x4){0.f, 0.f, 0.f, 0.f};
#pragma unroll
        for (int b = 0; b < 5; ++b) {
            v4u pw; pw.x = pk2(sc[b][0][0], sc[b][0][1]); pw.y = pk2(sc[b][0][2], sc[b][0][3]); pw.z = pk2(sc[b][1][0], sc[b][1][1]); pw.w = pk2(sc[b][1][2], sc[b][1][3]);
            const bf16x8 pf = __builtin_bit_cast(bf16x8, pw);
#pragma unroll
            for (int dt = 0; dt < 4; ++dt) { const LAS unsigned char* vr = lds + VT_OFF + (16 * dt + fr) * VP + (32 * (kb0 + b) + 4 * fg) * 2;
                const v2u lo = *(const LAS v2u*)vr, hi = *(const LAS v2u*)(vr + 32);
                v4u vw; vw.x = lo.x; vw.y = lo.y; vw.z = hi.x; vw.w = hi.y;
                o[dt] = __builtin_amdgcn_mfma_f32_16x16x32_bf16(__builtin_bit_cast(bf16x8, vw), pf, o[dt], 0, 0, 0); } }
        bf16* op = BR0 + (size_t)tok * 512 + head * 64 + 4 * fg;
#pragma unroll
        for (int dt = 0; dt < 4; ++dt) { v2u w; w.x = pk2(o[dt][0] * inv, o[dt][1] * inv); w.y = pk2(o[dt][2] * inv, o[dt][3] * inv); *(v2u*)(op + 16 * dt) = w; }
    }
}

__device__ __forceinline__ void unpack8(const v4u a, float (&v)[8]) { v[0] = bflo(a.x); v[1] = bfhi(a.x); v[2] = bflo(a.y); v[3] = bfhi(a.y); v[4] = bflo(a.z); v[5] = bfhi(a.z); v[6] = bflo(a.w); v[7] = bfhi(a.w); }
__device__ __forceinline__ void psc_unit(LAS unsigned char* lds, const bf16* PROJ, const float* convw, const bf16* PWT, const float* pscale, const bf16* SW, const float* sgub,
                                         bf16* BR1, bf16* BR2, bf16* BR3, int T, int hf) {
    constexpr int PP = 272;
    constexpr int PL_OFF = 0, PO_OFF = 38912, VT_OFF = 73728;
    int tid_ = threadIdx.x; asm volatile("" : "+v"(tid_)); const int tid = tid_, lane = tid & 63, wave = __builtin_amdgcn_readfirstlane(tid >> 6);
    const int fr = lane & 15, fg = lane >> 4;
    { const int c8 = tid & 31, tr = tid >> 5, ch = hf * 256 + c8 * 8, t0 = T * 128 + tr * 8;
      float w0[8], w1[8], w2[8];
#pragma unroll
      for (int i = 0; i < 8; ++i) { w0[i] = convw[ch + i]; w1[i] = convw[512 + ch + i]; w2[i] = convw[1024 + ch + i]; }
      const bf16* base = PROJ + (size_t)t0 * PROJ_COLS + ch;
      float zm2[8], zm1[8];
      { v4u a2 = (v4u){0u, 0u, 0u, 0u}, b2 = a2, a1 = a2, b1 = a2;
        if (t0 >= 2) { a2 = *(const v4u*)(base - 2 * PROJ_COLS + PC_CC); b2 = *(const v4u*)(base - 2 * PROJ_COLS + PC_CX); a1 = *(const v4u*)(base - PROJ_COLS + PC_CC); b1 = *(const v4u*)(base - PROJ_COLS + PC_CX); }
        float x[8], y[8]; unpack8(a2, x); unpack8(b2, y);
#pragma unroll
        for (int k = 0; k < 8; ++k) zm2[k] = x[k] * y[k];
        unpack8(a1, x); unpack8(b1, y);
#pragma unroll
        for (int k = 0; k < 8; ++k) zm1[k] = x[k] * y[k]; }
#pragma unroll
      for (int h = 0; h < 2; ++h) { v4u ca[4], xa[4], ga[4];
#pragma unroll
          for (int i = 0; i < 4; ++i) { const bf16* p = base + (size_t)(4 * h + i) * PROJ_COLS; ca[i] = *(const v4u*)(p + PC_CC); xa[i] = *(const v4u*)(p + PC_CX); ga[i] = *(const v4u*)(p + PC_CB); }
#pragma unroll
          for (int i = 0; i < 4; ++i) { float z[8], xx[8], gb[8], y[8]; unpack8(ca[i], z); unpack8(xa[i], xx); unpack8(ga[i], gb);
#pragma unroll
              for (int k = 0; k < 8; ++k) { z[k] *= xx[k]; y[k] = gb[k] * (w0[k] * zm2[k] + w1[k] * zm1[k] + w2[k] * z[k]); zm2[k] = zm1[k]; zm1[k] = z[k]; }
              v4u w; w.x = pk2(y[0], y[1]); w.y = pk2(y[2], y[3]); w.z = pk2(y[4], y[5]); w.w = pk2(y[6], y[7]);
              *(v4u*)(BR1 + (size_t)(t0 + 4 * h + i) * 512 + ch) = w; } } }
#pragma unroll 1
    for (int gi = 0; gi < 2; ++gi) {
        const int gp = 2 * hf + gi, win = 2 << gp;
        v4u pl[5], sv[4];
#pragma unroll
        for (int i = 0; i < 5; ++i) { const int q = tid + 512 * i, r = q >> 4, c8 = q & 15, t = T * 128 - 15 + r;
            pl[i] = (v4u){0u, 0u, 0u, 0u};
            if (r < 143 && t >= 0) pl[i] = *(const v4u*)(PROJ + (size_t)t * PROJ_COLS + PC_P + gp * 128 + c8 * 8); }
#pragma unroll
        for (int i = 0; i < 4; ++i) { const int q = tid + 512 * i, s_ = q >> 4, c8 = q & 15; sv[i] = *(const v4u*)(PROJ + (size_t)(T * 128 + s_) * PROJ_COLS + PC_SV + gp * 128 + c8 * 8); }
        bf16x8 pwf[4], wsf[4];
#pragma unroll
        for (int ks = 0; ks < 4; ++ks) { pwf[ks] = *(const bf16x8*)(PWT + (size_t)gp * 16384 + (16 * wave + fr) * 128 + 32 * ks + 8 * fg);
                                         wsf[ks] = *(const bf16x8*)(SW + (size_t)gp * 16384 + (16 * wave + fr) * 128 + 32 * ks + 8 * fg); }
        __syncthreads();
#pragma unroll
        for (int i = 0; i < 5; ++i) { const int q = tid + 512 * i, r = q >> 4, c8 = q & 15; if (r < 143) *(LAS v4u*)(lds + PL_OFF + r * PP + c8 * 16) = pl[i]; }
#pragma unroll
        for (int i = 0; i < 4; ++i) { const int q = tid + 512 * i, s_ = q >> 4, c8 = q & 15; const v4u vv = sv[i];
            LAS unsigned short* vt = (LAS unsigned short*)(lds + VT_OFF + (c8 * 8) * PP + s_ * 2);
            vt[0 * (PP / 2)] = (unsigned short)(vv.x & 0xffffu); vt[1 * (PP / 2)] = (unsigned short)(vv.x >> 16);
            vt[2 * (PP / 2)] = (unsigned short)(vv.y & 0xffffu); vt[3 * (PP / 2)] = (unsigned short)(vv.y >> 16);
            vt[4 * (PP / 2)] = (unsigned short)(vv.z & 0xffffu); vt[5 * (PP / 2)] = (unsigned short)(vv.z >> 16);
            vt[6 * (PP / 2)] = (unsigned short)(vv.w & 0xffffu); vt[7 * (PP / 2)] = (unsigned short)(vv.w >> 16); }
        __syncthreads();
        { const int c8 = tid & 15, tr = tid >> 4; const LAS unsigned char* pcol = lds + PL_OFF + c8 * 16; float s[8];
#pragma unroll
          for (int k = 0; k < 8; ++k) s[k] = 0.f;
          for (int i = 0; i < win; ++i) { float v[8]; unpack8(*(const LAS v4u*)(pcol + (tr * 4 + 15 - i) * PP), v);
#pragma unroll
              for (int k = 0; k < 8; ++k) s[k] += v[k]; }
#pragma unroll
          for (int tt = 0; tt < 4; ++tt) { const int tl = tr * 4 + tt, t = T * 128 + tl; float p0[8]; unpack8(*(const LAS v4u*)(pcol + (tl + 15) * PP), p0);
              if (tt > 0) { float old[8]; unpack8(*(const LAS v4u*)(pcol + (tl + 15 - win) * PP), old);
#pragma unroll
                  for (int k = 0; k < 8; ++k) s[k] += p0[k] - old[k]; }
              const float ic = 1.0f / (float)((t + 1) < win ? (t + 1) : win);
              v4u w; w.x = pk2(s[0] * ic - p0[0], s[1] * ic - p0[1]); w.y = pk2(s[2] * ic - p0[2], s[3] * ic - p0[3]); w.z = pk2(s[4] * ic - p0[4], s[5] * ic - p0[5]); w.w = pk2(s[6] * ic - p0[6], s[7] * ic - p0[7]);
              *(LAS v4u*)(lds + PO_OFF + tl * PP + c8 * 16) = w; } }
        { const int tl = 16 * wave + fr, t = T * 128 + tl; const float bias = sgub[gp * 128 + tl];
          v2u uw[8];
#pragma unroll
          for (int ct = 0; ct < 8; ++ct) uw[ct] = *(const v2u*)(PROJ + (size_t)t * PROJ_COLS + PC_U + gp * 128 + 16 * ct + 4 * fg);
#pragma unroll
          for (int ct = 0; ct < 8; ++ct) { f32x4 a = (f32x4){0.f, 0.f, 0.f, 0.f};
#pragma unroll
              for (int ks = 0; ks < 4; ++ks) { const bf16x8 afr = *(const LAS bf16x8*)(lds + VT_OFF + (16 * ct + fr) * PP + (32 * ks + 8 * fg) * 2);
                  a = __builtin_amdgcn_mfma_f32_16x16x32_bf16(afr, wsf[ks], a, 0, 0, 0); }
              v2u w; w.x = pk2(bflo(uw[ct].x) * (a[0] + bias), bfhi(uw[ct].x) * (a[1] + bias)); w.y = pk2(bflo(uw[ct].y) * (a[2] + bias), bfhi(uw[ct].y) * (a[3] + bias));
              *(v2u*)(BR3 + (size_t)t * 512 + gp * 128 + 16 * ct + 4 * fg) = w; } }
        __syncthreads();
        { const f32x4 ps = *(const f32x4*)(pscale + gp * 128 + 16 * wave + 4 * fg);
#pragma unroll
          for (int tt = 0; tt < 8; ++tt) { f32x4 a = (f32x4){0.f, 0.f, 0.f, 0.f};
#pragma unroll
              for (int ks = 0; ks < 4; ++ks) { const bf16x8 bfr = *(const LAS bf16x8*)(lds + PO_OFF + (16 * tt + fr) * PP + (32 * ks + 8 * fg) * 2);
                  a = __builtin_amdgcn_mfma_f32_16x16x32_bf16(pwf[ks], bfr, a, 0, 0, 0); }
              v2u w; w.x = pk2(a[0] * ps[0], a[1] * ps[1]); w.y = pk2(a[2] * ps[2], a[3] * ps[3]);
              *(v2u*)(BR2 + (size_t)(T * 128 + 16 * tt + fr) * 512 + gp * 128 + 16 * wave + 4 * fg) = w; } }
    }
}

typedef const unsigned char __attribute__((address_space(4)))* kaptr_t;
__device__ __forceinline__ kaptr_t ka_get() { kaptr_t p = (kaptr_t)__builtin_amdgcn_kernarg_segment_ptr(); asm volatile("" : "+s"(p)); return p; }
#define KIN(ka, k) (*(const float* const __attribute__((address_space(4)))*)((ka) + 8 * (k)))
#define KOUT(ka) (*(float* const __attribute__((address_space(4)))*)((ka) + 168))
#define KWS(ka) (*(unsigned char* const __attribute__((address_space(4)))*)((ka) + 176))

__global__ void __launch_bounds__(NWAVES * 64, 2) trunk_fwd(Args args) {
    extern __shared__ __attribute__((aligned(16))) unsigned char lds_raw[];
    LAS unsigned char* lds = (LAS unsigned char*)lds_raw;
    volatile LAS unsigned* MISC = (volatile LAS unsigned*)(lds + MISC_OFF);
    const int G = gridDim.x, bx = blockIdx.x;
    for (int u = threadIdx.x; u < (LDS_BYTES - RING_BYTES) / 4; u += NWAVES * 64) ((LAS unsigned*)(lds + RING_BYTES))[u] = 0u;
    __syncthreads();
    XcdBarrier bar; bar.bar = (unsigned*)(args.ws + WS_CTL) + CW_BAR; bar.x = 0; bar.st = MISC + 8;
    if (!MK_PER_PHASE) bar = xcd_barrier_post((unsigned*)(args.ws + WS_CTL) + CW_BAR, MISC + 8);
    const int lo = args.ph_lo, hi = args.ph_hi;
#define IN(k) (lo <= (k) && (k) < hi)
#define SEAM_IF(c) do { if (c) { if (MK_PER_PHASE) { if (threadIdx.x == 0) __hip_atomic_store((unsigned*)(KWS(ka_get()) + WS_CTL) + CW_TMO, 0xBADBA0u, __ATOMIC_RELAXED, __HIP_MEMORY_SCOPE_AGENT); } \
        else { XcdBarrier b_; b_.bar = (unsigned*)(KWS(ka_get()) + WS_CTL) + CW_BAR; b_.x = xb_xcc_id(); b_.st = MISC + 8; xcd_barrier(b_); } } } while (0)
#define SEAM(k) SEAM_IF((k) + 1 < hi)

    if (IN(0)) {
        kaptr_t ka = ka_get(); unsigned char* ws = KWS(ka);
        const int tid = threadIdx.x, lane = tid & 63, wave = __builtin_amdgcn_readfirstlane(tid >> 6), gw = bx * NWAVES + wave, NGW = G * NWAVES;
        bf16* const WIN_T = (bf16*)(ws + WS_WIN); bf16* const WBR_T = (bf16*)(ws + WS_WBR); bf16* const WOUT_T = (bf16*)(ws + WS_WOUT);
        bf16* const DGU_T = (bf16*)(ws + WS_DGU); bf16* const DD_T = (bf16*)(ws + WS_DD); bf16* const MGU_T = (bf16*)(ws + WS_MGU); bf16* const MD_T = (bf16*)(ws + WS_MD);
        bf16* const PWT = (bf16*)(ws + WS_PWT); bf16* const SW = (bf16*)(ws + WS_SW); bf16* const XB = (bf16*)(ws + WS_XB); float* const SS = (float*)(ws + WS_SS);
        { LAS unsigned char* scr = lds + wave * 8448;
          constexpr int I_WINP = 16 * 60, I_WING = 8 * 64, I_WIN = I_WINP + I_WING, I_WBR = 8 * 16, I_WOUT = 16 * 16, I_FF = 16 * 44, I_FF8 = 8 * 44, I_PW = 4;
          constexpr int S1 = NL * I_WIN, S2 = S1 + NL * 4 * I_WBR, S3 = S2 + NL * I_WOUT, S4 = S3 + 2 * 3 * I_FF, S5 = S4 + (MOE0_F8 ? 0 : NE) * 3 * I_FF, S6 = S5 + (MOE0_F8 ? 2 * NE : NE) * 3 * I_FF8, S7 = S6 + NL * 4 * I_PW;
#pragma unroll 1
          for (int it = gw; it < S7; it += NGW) {
            const float* W; const float* gk = nullptr; bf16* WT; int K, N, il = 0, roff = 0, f8 = 0, item;
            int n_lo = 0, ncols = 0;
            if (it < S1) { const int l = it / I_WIN, r = it - l * I_WIN; W = KIN(ka, IN_WIN) + (size_t)l * D * IN_COLS; K = D; N = IN_COLS; gk = KIN(ka, IN_LNMIX) + l * D;
                if (r < I_WINP) { item = r; ncols = PROJ_COLS; WT = WIN_T + (size_t)l * PROJ_COLS * D; }
                else { item = r - I_WINP; n_lo = PROJ_COLS; ncols = GATE_COLS; f8 = 1; WT = (bf16*)(ws + WS_WIN8 + (size_t)l * GATE_COLS * D); } }
            else if (it < S2) { const int r = it - S1, q = r / I_WBR; item = r - q * I_WBR; W = KIN(ka, IN_WBR) + (size_t)q * 512 * D; K = 512; N = D; WT = WBR_T + (size_t)q * D * 512; }
            else if (it < S3) { const int r = it - S2, l = r / I_WOUT; item = r - l * I_WOUT; W = KIN(ka, IN_WOUT) + (size_t)l * D * D; K = D; N = D; WT = WOUT_T + (size_t)l * D * D; }
            else if (it < S5) { const bool moe = it >= S4; const int r = it - (moe ? S4 : S3), q = r / (3 * I_FF), r2 = r - q * 3 * I_FF, w = r2 / I_FF; item = r2 - w * I_FF;
                const int lay = moe ? 1 : 2 * q;
                if (!moe && (((DENSE_F8_MASK >> q) & 1) || (w == 2 && ((DENSE_F2_F8_MASK >> q) & 1)))) f8 = 2;
                if (w < 2) { W = KIN(ka, moe ? (w ? IN_MU : IN_MG) : (w ? IN_DU : IN_DG)) + (size_t)q * D * FF; K = D; N = FF; WT = (moe ? MGU_T : DGU_T) + (size_t)q * 2 * FF * D; gk = KIN(ka, IN_LNFFN) + lay * D; il = 1; roff = w * 128; }
                else { W = KIN(ka, moe ? IN_MD : IN_DD) + (size_t)q * FF * D; K = FF; N = D; WT = (moe ? MD_T : DD_T) + (size_t)q * D * FF; } }
            else if (it < S6) { const int r = it - S5, q0 = r / (3 * I_FF8), r2 = r - q0 * 3 * I_FF8, w = r2 / I_FF8; item = r2 - w * I_FF8; f8 = 1;
                const int q = MOE0_F8 ? q0 : NE + q0, inst = q >> 3, e = q & 7;
                if (w < 2) { W = KIN(ka, w ? IN_MU : IN_MG) + (size_t)q * D * FF; K = D; N = FF; WT = (bf16*)((unsigned char*)(MGU_T + (size_t)inst * NE * 2 * FF * D) + (size_t)e * 2 * FF * D); gk = KIN(ka, IN_LNFFN) + (2 * inst + 1) * D; il = 1; roff = w * 128; }
                else { W = KIN(ka, IN_MD) + (size_t)q * FF * D; K = FF; N = D; WT = (bf16*)((unsigned char*)(MD_T + (size_t)inst * NE * D * FF) + (size_t)e * D * FF); } }
            else { const int r = it - S6, q = r / I_PW; item = r - q * I_PW; W = KIN(ka, IN_POOLW) + (size_t)q * 16384; K = 128; N = 128; WT = PWT + (size_t)q * 16384; }
            if (ncols == 0) ncols = N;
            if (f8 == 2) { const int nblk = ncols >> 6, kb = item / nblk; if (kb & 1) continue;
                p0_item(W, K, N, n_lo, ncols, WT, gk, il, roff, 1, scr, item, lane, true); item += nblk; f8 = 1; }
            else if (f8) { const int nblk = ncols >> 6, kb2 = item / nblk, nb = item - kb2 * nblk;
                p0_item(W, K, N, n_lo, ncols, WT, gk, il, roff, 1, scr, (2 * kb2) * nblk + nb, lane, true); item = (2 * kb2 + 1) * nblk + nb; }
            p0_item(W, K, N, n_lo, ncols, WT, gk, il, roff, f8, scr, item, lane, it < S6);
          } }
        { const float* sw = KIN(ka, IN_SGUW);
          for (int i = (bx * NWAVES * 64 + tid); i < NL * 4 * 16384 / 4; i += G * NWAVES * 64) { const f32x4 v = *(const f32x4*)(sw + (size_t)i * 4);
            const int e = i * 4, t = (e >> 7) & 127, s = e & 127;
            v2u w; w.x = pk2(s <= t ? v[0] : 0.f, s + 1 <= t ? v[1] : 0.f); w.y = pk2(s + 2 <= t ? v[2] : 0.f, s + 3 <= t ? v[3] : 0.f);
            *(v2u*)(SW + (size_t)e) = w; } }
        { const float* x0 = KIN(ka, IN_X);
#pragma unroll 1
          for (int m0 = gw; m0 < M; m0 += 4 * NGW) {
            f32x4 v[4][4];
#pragma unroll
            for (int q = 0; q < 4; ++q) { const int m = (m0 + q * NGW) < M ? (m0 + q * NGW) : m0; const f32x4* xr = (const f32x4*)(x0 + (size_t)m * D) + lane;
#pragma unroll
                for (int j = 0; j < 4; ++j) v[q][j] = xr[64 * j]; }
#pragma unroll
            for (int q = 0; q < 4; ++q) { const int m = m0 + q * NGW; if (m < M) { float s = 0.f;
#pragma unroll
                for (int j = 0; j < 4; ++j) { const f32x4 w4 = v[q][j]; s += (w4[0] * w4[0] + w4[1] * w4[1]) + (w4[2] * w4[2] + w4[3] * w4[3]);
                    v2u w; w.x = pk2(w4[0], w4[1]); w.y = pk2(w4[2], w4[3]); *((v2u*)(XB + (size_t)m * D) + lane + 64 * j) = w;
                    *((unsigned*)(ws + WS_X8 + (size_t)m * D) + lane + 64 * j) = pk4_fp8(w4[0], w4[1], w4[2], w4[3]); }
                s = wave_sum(s);
                if (lane < 16) SS[((size_t)(lane >> 2) * M + m) * 4 + (lane & 3)] = lane == 0 ? s : 0.f; } } } }
        SEAM(0);
    }

#pragma unroll 1
    for (int l = 0; l < NL; ++l) {
        const int pb = 1 + l * PH_PER_LAYER;
        if (IN(pb + 0)) {
            kaptr_t ka = ka_get(); unsigned char* ws = KWS(ka);
            pg8::StaticOrder S; S.init(M / 256, IN_COLS / 256, G, bx);
            Unit u0; u0.pm = -1; u0.pn = 0; const bool have0 = S.next(0, u0);
            LAS float* RSL = (LAS float*)(lds + RSL_OFF);
            { int t_ = threadIdx.x; asm volatile("" : "+v"(t_)); if (have0 && t_ < 256) RSL[t_] = row_rscale((const float*)(ws + WS_SS), u0.pm * 256 + t_); }
            __syncthreads();
            EpiG1 E{(bf16*)(ws + WS_PROJ), (bf16*)(ws + WS_G), (const float*)(ws + WS_SS), RSL, u0.pm};
            pg8::gemm_phase_mixed(lds, (const bf16*)(ws + WS_XB), (const bf16*)(ws + WS_WIN) + (size_t)l * PROJ_COLS * D, ws + WS_X8, ws + WS_WIN8 + (size_t)l * GATE_COLS * D, PROJ_COLS / 256, S, E);
            SEAM(pb + 0);
        }
        if (IN(pb + 1)) {
            kaptr_t ka = ka_get(); unsigned char* ws = KWS(ka);
            const bf16* PROJ = (const bf16*)(ws + WS_PROJ); bf16* BR = (bf16*)(ws + WS_BR);
            { const float* sinks = KIN(ka, IN_SINK) + l * 8;
              for (int u = bx; u < 256; u += G) att_unit(lds, PROJ, sinks, BR, u >> 1, u & 1); }
            { const float* convw = KIN(ka, IN_CONVW) + l * 1536; const float* pscale = KIN(ka, IN_POOLS) + l * 512; const float* sgub = KIN(ka, IN_SGUB) + l * 512;
              const bf16* PWT = (const bf16*)(ws + WS_PWT) + (size_t)l * 4 * 16384; const bf16* SW = (const bf16*)(ws + WS_SW) + (size_t)l * 4 * 16384;
              for (int u = bx; u < 256; u += G) psc_unit(lds, PROJ, convw, PWT, pscale, SW, sgub, BR + (size_t)M * 512, BR + (size_t)2 * M * 512, BR + (size_t)3 * M * 512, u >> 1, u & 1); }
            __syncthreads();
            SEAM(pb + 1);
        }
        if (IN(pb + 2)) {
            kaptr_t ka = ka_get(); unsigned char* ws = KWS(ka);
            pg8::Gemm g{(const bf16*)(ws + WS_BR), (const bf16*)(ws + WS_WBR) + (size_t)l * 4 * D * 512, 512}; B1Order S; S.so.init(64, 4, G, bx);
            EpiB1 E{(const unsigned char*)(ws + WS_G), (bf16*)(ws + WS_MRG)};
            pg8::gemm_phase<false>(lds, g, S, E);
            SEAM(pb + 2);
        }
        if (IN(pb + 3)) {
            kaptr_t ka = ka_get(); unsigned char* ws = KWS(ka);
            pg8::Gemm g{(const bf16*)(ws + WS_MRG), (const bf16*)(ws + WS_WOUT) + (size_t)l * D * D, D}; pg8::StaticOrder S; S.init(M / 256, D / 256, G, bx);
            EpiRes<DENSE_F8_MASK != 0, false> E{(bf16*)(ws + WS_XB), (float*)(ws + WS_SS), (((l & 1) == 0) && ((DENSE_F8_MASK >> (l >> 1)) & 1)) ? ws + WS_X8 : nullptr};
            pg8::gemm_phase<false>(lds, g, S, E);
            SEAM(pb + 3);
        }
        if ((l & 1) == 0) {
            const int i = l >> 1;
            if (IN(pb + 4)) {
                kaptr_t ka = ka_get(); unsigned char* ws = KWS(ka);
                pg8::StaticOrder S; S.init(M / 256, 22, G, bx);
                Unit u0; u0.pm = -1; u0.pn = 0; const bool have0 = S.next(0, u0);
                LAS float* RSL = (LAS float*)(lds + RSL_OFF);
                { int t_ = threadIdx.x; asm volatile("" : "+v"(t_)); if (have0 && t_ < 256) RSL[t_] = row_rscale((const float*)(ws + WS_SS), u0.pm * 256 + t_); }
                __syncthreads();
                if ((DENSE_F8_MASK >> i) & 1) { pg8::Gemm g{(const bf16*)(ws + WS_X8), (const bf16*)(ws + WS_DGU) + (size_t)i * 2 * FF * D, D / 2}; EpiGU8 E{ws + WS_ACT, RSL, (const float*)(ws + WS_SS), u0.pm}; pg8::gemm_phase<true>(lds, g, S, E); }
                else { pg8::Gemm g{(const bf16*)(ws + WS_XB), (const bf16*)(ws + WS_DGU) + (size_t)i * 2 * FF * D, D}; EpiGU<true, (DENSE_F2_F8_MASK & ~DENSE_F8_MASK) != 0> E{(bf16*)(ws + WS_ACT), (const float*)(ws + WS_SS), RSL, u0.pm}; pg8::gemm_phase<false>(lds, g, S, E); }
                SEAM(pb + 4);
            }
            if (IN(pb + 5)) {
                kaptr_t ka = ka_get(); unsigned char* ws = KWS(ka);
                pg8::StaticOrder S; S.init(M / 256, D / 256, G, bx);
                if (((DENSE_F8_MASK | DENSE_F2_F8_MASK) >> i) & 1) { pg8::Gemm g{(const bf16*)(ws + WS_ACT), (const bf16*)(ws + WS_DD) + (size_t)i * D * FF, FF / 2}; EpiRes<true, true> E{(bf16*)(ws + WS_XB), (float*)(ws + WS_SS), ws + WS_X8}; pg8::gemm_phase<true>(lds, g, S, E); }
                else { pg8::Gemm g{(const bf16*)(ws + WS_ACT), (const bf16*)(ws + WS_DD) + (size_t)i * D * FF, FF}; EpiRes<true, false> E{(bf16*)(ws + WS_XB), (float*)(ws + WS_SS), ws + WS_X8}; pg8::gemm_phase<false>(lds, g, S, E); }
                SEAM_IF(pb + 9 < hi);
            }
        } else {
            const int i = l >> 1;
            if (IN(pb + 4)) {
                kaptr_t ka = ka_get(); unsigned char* ws = KWS(ka);
                int tid_ = threadIdx.x; asm volatile("" : "+v"(tid_)); const int tid = tid_, lane = tid & 63, wave = __builtin_amdgcn_readfirstlane(tid >> 6);
                unsigned* CNT = (unsigned*)(ws + WS_CTL) + CW_CNT + i * 64;
                const bf16* XBr = (const bf16*)(ws + WS_XB);
                int* const TOKE = (int*)(ws + WS_TOK); int* const TOKP = TOKE + 2 * M; float* const TOKW = (float*)(TOKP + 2 * M);
                LAS float* WR = (LAS float*)lds;
                LAS int* LE = (LAS int*)(lds + 32768);
                LAS int* LP = (LAS int*)(lds + 33792);
                LAS unsigned char* ROWS = lds + 40960;
                unsigned char* XGF = ws + WS_XG;
                const float* rw = KIN(ka, IN_RW) + (size_t)i * D * NE; const float* gk = KIN(ka, IN_LNFFN) + l * D; const float* rb = KIN(ka, IN_RB) + i * NE;
                __syncthreads();
                { const f32x4* rw4 = (const f32x4*)(rw + (size_t)tid * 16); const f32x4 a0 = rw4[0], a1 = rw4[1], a2 = rw4[2], a3 = rw4[3];
                  const float g0 = gk[2 * tid], g1 = gk[2 * tid + 1];
#pragma unroll
                  for (int e = 0; e < 4; ++e) { WR[e * D + 2 * tid] = a0[e] * g0; WR[(e + 4) * D + 2 * tid] = a1[e] * g0; WR[e * D + 2 * tid + 1] = a2[e] * g1; WR[(e + 4) * D + 2 * tid + 1] = a3[e] * g1; } }
                __syncthreads();
                for (int ch = bx; ch < M / 64; ch += G) {
                    v2u va[8][4];
#pragma unroll
                    for (int ti = 0; ti < 8; ++ti) { const v2u* xr0 = (const v2u*)(XBr + (size_t)(ch * 64 + wave * 8 + ti) * D) + lane;
#pragma unroll
                      for (int j = 0; j < 4; ++j) va[ti][j] = xr0[64 * j]; }
#pragma unroll
                    for (int hb = 0; hb < 2; ++hb) {
                        f32x4 v[4][4]; float s[4], d[4][8];
#pragma unroll
                        for (int q = 0; q < 4; ++q) { s[q] = 0.f;
#pragma unroll
                            for (int j = 0; j < 4; ++j) { const v2u a = va[hb * 4 + q][j]; v[q][j] = (f32x4){bflo(a.x), bfhi(a.x), bflo(a.y), bfhi(a.y)};
                                s[q] += (v[q][j][0] * v[q][j][0] + v[q][j][1] * v[q][j][1]) + (v[q][j][2] * v[q][j][2] + v[q][j][3] * v[q][j][3]); }
#pragma unroll
                            for (int e = 0; e < 8; ++e) d[q][e] = 0.f; }
#pragma unroll
                        for (int e = 0; e < 8; ++e)
#pragma unroll
                            for (int j = 0; j < 4; ++j) { const f32x4 w = *((const LAS f32x4*)(WR + e * D) + lane + 64 * j);
#pragma unroll
                                for (int q = 0; q < 4; ++q) d[q][e] += (v[q][j][0] * w[0] + v[q][j][1] * w[1]) + (v[q][j][2] * w[2] + v[q][j][3] * w[3]); }
#pragma unroll
                        for (int q = 0; q < 4; ++q) { const int tl = wave * 8 + hb * 4 + q, t = ch * 64 + tl;
                            const float r = 1.0f / sqrtf(wave_sum(s[q]) * (1.0f / D) + RMS_EPS);
#pragma unroll
                            for (int j = 0; j < 4; ++j) *((LAS unsigned*)(ROWS + tl * 1024) + lane + 64 * j) = pk4_fp8(v[q][j][0] * r, v[q][j][1] * r, v[q][j][2] * r, v[q][j][3] * r);
                            float lg[8];
#pragma unroll
                            for (int e = 0; e < 8; ++e) lg[e] = wave_sum(d[q][e]) * r + rb[e];
                            int i0 = 0; float v0 = lg[0];
#pragma unroll
                            for (int e = 1; e < 8; ++e) if (lg[e] > v0) { v0 = lg[e]; i0 = e; }
                            int i1 = -1; float v1 = -3.0e38f;
#pragma unroll
                            for (int e = 0; e < 8; ++e) if (e != i0 && lg[e] > v1) { v1 = lg[e]; i1 = e; }
                            const float w1 = 1.0f / (1.0f + __expf(v0 - v1)), w0 = 1.0f - w1;
                            if (lane == 0) { LE[tl * 2] = i0; LE[tl * 2 + 1] = i1; TOKE[t * 2] = i0; TOKE[t * 2 + 1] = i1; TOKW[t * 2] = w0; TOKW[t * 2 + 1] = w1; } } }
                    __syncthreads();
                    if (tid < NE) { const int e = tid; int cnt = 0;
                        for (int q = 0; q < 128; ++q) cnt += (LE[q] == e);
                        int pos = (int)__hip_atomic_fetch_add(CNT + e, (unsigned)cnt, __ATOMIC_RELAXED, __HIP_MEMORY_SCOPE_AGENT);
                        for (int q = 0; q < 128; ++q) if (LE[q] == e) { const int t = ch * 64 + (q >> 1); TOKP[t * 2 + (q & 1)] = pos; LP[q] = pos; ++pos; } }
                    __syncthreads();
#pragma unroll
                    for (int ti = 0; ti < 8; ++ti) { const int tl = wave * 8 + ti; const v4u rowv = *(const LAS v4u*)(ROWS + tl * 1024 + lane * 16);
#pragma unroll
                        for (int k = 0; k < 2; ++k) { const int e = LE[tl * 2 + k], pos = LP[tl * 2 + k]; *(v4u*)(XGF + ((size_t)e * XG_CAP + pos) * D + lane * 16) = rowv; } }
                    __syncthreads();
                }
                SEAM(pb + 4);
            }
            if (IN(pb + 6)) {
                kaptr_t ka = ka_get(); unsigned char* ws = KWS(ka);
                unsigned* CNT = (unsigned*)(ws + WS_CTL) + CW_CNT + i * 64;
                int tb[9]; tb[0] = 0;
#pragma unroll
                for (int e = 0; e < 8; ++e) { const int c = (int)__hip_atomic_load(CNT + e, __ATOMIC_RELAXED, __HIP_MEMORY_SCOPE_AGENT); tb[e + 1] = tb[e] + ((c + 255) >> 8); }
                MoeOrder S; S.so.init(tb[8], 22, G, bx);
                S.tb1 = tb[1]; S.tb2 = tb[2]; S.tb3 = tb[3]; S.tb4 = tb[4]; S.tb5 = tb[5]; S.tb6 = tb[6]; S.tb7 = tb[7]; S.nN = 22; S.fixedA = 1;
                if (i == 0 && !MOE0_F8) { pg8::Gemm g{(const bf16*)(ws + WS_XG), (const bf16*)(ws + WS_MGU), D}; EpiGU<false> E{(bf16*)(ws + WS_ACT), nullptr, nullptr, -1}; pg8::gemm_phase<false>(lds, g, S, E); }
                else { pg8::Gemm g{(const bf16*)(ws + WS_XG), (const bf16*)(ws + WS_MGU) + (size_t)i * NE * 2 * FF * D, D / 2}; EpiGU8 E{ws + WS_ACT, nullptr, nullptr, -1}; pg8::gemm_phase<true>(lds, g, S, E); }
                SEAM(pb + 6);
            }
            if (IN(pb + 7)) {
                kaptr_t ka = ka_get(); unsigned char* ws = KWS(ka);
                unsigned* CNT = (unsigned*)(ws + WS_CTL) + CW_CNT + i * 64;
                int tb[9]; tb[0] = 0;
#pragma unroll
                for (int e = 0; e < 8; ++e) { const int c = (int)__hip_atomic_load(CNT + e, __ATOMIC_RELAXED, __HIP_MEMORY_SCOPE_AGENT); tb[e + 1] = tb[e] + ((c + 255) >> 8); }
                MoeOrder S; S.so.init(tb[8], 4, G, bx);
                S.tb1 = tb[1]; S.tb2 = tb[2]; S.tb3 = tb[3]; S.tb4 = tb[4]; S.tb5 = tb[5]; S.tb6 = tb[6]; S.tb7 = tb[7]; S.nN = 4; S.fixedA = 0;
                if (i == 0 && !MOE0_F8) { pg8::Gemm g{(const bf16*)(ws + WS_ACT), (const bf16*)(ws + WS_MD), FF}; EpiY E{(bf16*)(ws + WS_Y), 1.0f}; pg8::gemm_phase<false>(lds, g, S, E); }
                else { pg8::Gemm g{(const bf16*)(ws + WS_ACT), (const bf16*)(ws + WS_MD) + (size_t)i * NE * D * FF, FF / 2}; EpiY E{(bf16*)(ws + WS_Y), 1.0f / (W8_SCALE * A8_SCALE)}; pg8::gemm_phase<true>(lds, g, S, E); }
                SEAM(pb + 7);
            }
            if (IN(pb + 8)) {
                kaptr_t ka = ka_get(); unsigned char* ws = KWS(ka);
                int tid_ = threadIdx.x; asm volatile("" : "+v"(tid_)); const int tid = tid_, lane = tid & 63, wave = __builtin_amdgcn_readfirstlane(tid >> 6), gw = bx * NWAVES + wave, NGW = G * NWAVES;
                unsigned* CNT = (unsigned*)(ws + WS_CTL) + CW_CNT + i * 64;
                int tb[9]; tb[0] = 0;
#pragma unroll
                for (int e = 0; e < 8; ++e) { const int c = (int)__hip_atomic_load(CNT + e, __ATOMIC_RELAXED, __HIP_MEMORY_SCOPE_AGENT); tb[e + 1] = tb[e] + ((c + 255) >> 8); }
                bf16* XB = (bf16*)(ws + WS_XB); float* SS = (float*)(ws + WS_SS); const bf16* Y = (const bf16*)(ws + WS_Y);
                const int* TOKE = (const int*)(ws + WS_TOK); const int* TOKP = TOKE + 2 * M; const float* TOKW = (const float*)(TOKP + 2 * M);
                const bool last = (l == NL - 1);
                const float* gfin = KIN(ka, IN_LNF); float* outp = KOUT(ka);
#pragma unroll 1
                for (int t0 = gw; t0 < M; t0 += 4 * NGW) {
                    int ek[4][2], pk[4][2]; float wk[4][2];
#pragma unroll
                    for (int q = 0; q < 4; ++q) { const int t = (t0 + q * NGW) < M ? (t0 + q * NGW) : t0;
#pragma unroll
                        for (int k = 0; k < 2; ++k) { ek[q][k] = TOKE[t * 2 + k]; pk[q][k] = TOKP[t * 2 + k]; wk[q][k] = TOKW[t * 2 + k]; } }
                    v2u xv[4][4], ya[4][4], yb[4][4];
#pragma unroll
                    for (int q = 0; q < 4; ++q) { const int t = (t0 + q * NGW) < M ? (t0 + q * NGW) : t0;
                        const int e0 = __builtin_amdgcn_readfirstlane(ek[q][0]), e1 = __builtin_amdgcn_readfirstlane(ek[q][1]), p0 = __builtin_amdgcn_readfirstlane(pk[q][0]), p1 = __builtin_amdgcn_readfirstlane(pk[q][1]);
                        int b0 = 0, b1 = 0;
#pragma unroll
                        for (int qq = 1; qq < 8; ++qq) { b0 = (e0 == qq) ? tb[qq] : b0; b1 = (e1 == qq) ? tb[qq] : b1; }
                        const v2u* y0 = (const v2u*)(Y + (size_t)(b0 * 256 + p0) * D) + lane; const v2u* y1 = (const v2u*)(Y + (size_t)(b1 * 256 + p1) * D) + lane;
                        const v2u* xr = (const v2u*)(XB + (size_t)t * D) + lane;
#pragma unroll
                        for (int j = 0; j < 4; ++j) { xv[q][j] = xr[64 * j]; ya[q][j] = y0[64 * j]; yb[q][j] = y1[64 * j]; } }
#pragma unroll
                    for (int q = 0; q < 4; ++q) { const int t = t0 + q * NGW; if (t < M) { const float w0 = wk[q][0], w1 = wk[q][1];
                        f32x4 v[4]; float s = 0.f;
#pragma unroll
                        for (int j = 0; j < 4; ++j) { const v2u a = ya[q][j], b = yb[q][j]; f32x4 x = (f32x4){bflo(xv[q][j].x), bfhi(xv[q][j].x), bflo(xv[q][j].y), bfhi(xv[q][j].y)};
                            x[0] += w0 * bflo(a.x) + w1 * bflo(b.x); x[1] += w0 * bfhi(a.x) + w1 * bfhi(b.x); x[2] += w0 * bflo(a.y) + w1 * bflo(b.y); x[3] += w0 * bfhi(a.y) + w1 * bfhi(b.y);
                            v[j] = x; s += (x[0] * x[0] + x[1] * x[1]) + (x[2] * x[2] + x[3] * x[3]); }
                        s = wave_sum(s);
                        if (!last) {
#pragma unroll
                            for (int j = 0; j < 4; ++j) { v2u w; w.x = pk2(v[j][0], v[j][1]); w.y = pk2(v[j][2], v[j][3]); *((v2u*)(XB + (size_t)t * D) + lane + 64 * j) = w;
                                *((unsigned*)(ws + WS_X8 + (size_t)t * D) + lane + 64 * j) = pk4_fp8(v[j][0], v[j][1], v[j][2], v[j][3]); }
                            if (lane < 16) SS[((size_t)(lane >> 2) * M + t) * 4 + (lane & 3)] = lane == 0 ? s : 0.f;
                        } else {
                            const float r = 1.0f / sqrtf(s * (1.0f / D) + RMS_EPS);
                            const f32x4* gf = (const f32x4*)gfin + lane; f32x4* orow = (f32x4*)(outp + (size_t)t * D) + lane;
#pragma unroll
                            for (int j = 0; j < 4; ++j) orow[64 * j] = v[j] * r * gf[64 * j];
                        } } }
                }
                SEAM(pb + 8);
            }
        }
    }
#undef IN
#undef SEAM
#undef SEAM_IF
}

extern "C" void kernel_launch(void* const* d_in, const int* in_sizes, int n_in, void* d_out, int out_size, void* d_ws, size_t ws_size, hipStream_t stream) {
    static int grid = 0;
    if (grid == 0) {
        if (n_in != 21 || in_sizes[0] != M * D || out_size != M * D || ws_size < WS_END) { fprintf(stderr, "kernel_launch: unexpected shapes / workspace (%zu < %zu)\n", ws_size, (size_t)WS_END); grid = -1; return; }
        int dev = 0, cus = 0, per_cu = 0;
        if (hipGetDevice(&dev) != hipSuccess || hipDeviceGetAttribute(&cus, hipDeviceAttributeMultiprocessorCount, dev) != hipSuccess) { grid = -1; return; }
        if (hipFuncSetAttribute((const void*)trunk_fwd, hipFuncAttributeMaxDynamicSharedMemorySize, LDS_BYTES) != hipSuccess) { fprintf(stderr, "kernel_launch: hipFuncSetAttribute failed\n"); grid = -1; return; }
        if (hipOccupancyMaxActiveBlocksPerMultiprocessor(&per_cu, (const void*)trunk_fwd, NWAVES * 64, LDS_BYTES) != hipSuccess || per_cu < 1) { fprintf(stderr, "kernel_launch: occupancy query says %d\n", per_cu); (void)hipGetLastError(); grid = -1; return; }
        grid = cus;
    }
    if (grid < 0) return;
    if (hipMemsetAsync((char*)d_ws + WS_CTL, 0, CTL_ZERO_BYTES, stream) != hipSuccess) return;
    Args a{};
    for (int i = 0; i < 21; ++i) a.in[i] = (const float*)d_in[i];
    a.out = (float*)d_out; a.ws = (unsigned char*)d_ws;
#if MK_PER_PHASE
    for (int p = 0; p < N_PHASES; ++p) {
        if (p >= 1) { const int l = (p - 1) / PH_PER_LAYER, k = (p - 1) % PH_PER_LAYER; if ((l & 1) == 0 && k >= 6) continue; }
        a.ph_lo = p; a.ph_hi = p + 1;
        hipLaunchKernelGGL(trunk_fwd, dim3(grid), dim3(NWAVES * 64), LDS_BYTES, stream, a);
    }
#else
    a.ph_lo = 0; a.ph_hi = N_PHASES;
    hipLaunchKernelGGL(trunk_fwd, dim3(grid), dim3(NWAVES * 64), LDS_BYTES, stream, a);
#endif
}
```
